# Optimizing an MI355X kernel written in HIP

```python
import jax, jax.numpy as jnp
from jax import lax
import numpy as np

D_MODEL = 1024
BATCH = 16
SEQ = 2048
DEPTH = 2

RG_WIDTH = 1024
RG_BLOCKS = 16
RG_BLOCK_DIM = RG_WIDTH // RG_BLOCKS
CONV_WIDTH = 4
RG_C = 8.0
SB_HEADS = 8
SB_HEAD_DIM = 64
SB_WIDTH = SB_HEADS * SB_HEAD_DIM
FOX_HEADS = 8
FOX_HEAD_DIM = 64
FOX_WIDTH = FOX_HEADS * FOX_HEAD_DIM
N_BRANCHES = 3
D_FF = 2816
Q_BLOCK = 128
N_SUBLAYERS = 3
EPS = 1e-6
IN_SIZES = (RG_WIDTH, RG_WIDTH, 3 * SB_WIDTH, 3 * FOX_WIDTH, FOX_HEADS, N_BRANCHES * D_MODEL)
N_IN = sum(IN_SIZES)

kernel_name = "hybrid_rglru_stickbreak_fox_macaron_adaln"


def _rmsnorm(x, gain):
    x32 = x.astype(jnp.float32)
    y = x32 * lax.rsqrt(jnp.mean(x32 * x32, axis=-1, keepdims=True) + EPS)
    return y.astype(x.dtype) * gain


def _modulate(h, shift, scale):
    return h * (1.0 + scale[:, None, :]) + shift[:, None, :]


def _swiglu(h, w1, w3, w2):
    return (jax.nn.silu(h @ w1) * (h @ w3)) @ w2


def _causal_depthwise_conv(x, w, b):
    y = lax.conv_general_dilated(
        x, w[:, None, :].astype(x.dtype), window_strides=(1,), padding=[(CONV_WIDTH - 1, 0)],
        dimension_numbers=('NWC', 'WIO', 'NWC'), feature_group_count=x.shape[-1])
    return y + b


def _block_diag(x, w, b):
    bsz, slen, _ = x.shape
    xb = x.reshape(bsz, slen, RG_BLOCKS, RG_BLOCK_DIM)
    return jnp.einsum('bsnd,nde->bsne', xb, w).reshape(bsz, slen, RG_WIDTH) + b


def _rg_lru(x, w_a, b_a, w_x, b_x, lam):
    x32 = x.astype(jnp.float32)
    r = jax.nn.sigmoid(_block_diag(x, w_a, b_a).astype(jnp.float32))
    i = jax.nn.sigmoid(_block_diag(x, w_x, b_x).astype(jnp.float32))
    log_a = -RG_C * r * jax.nn.softplus(-lam.astype(jnp.float32))
    a = jnp.exp(log_a)
    u = jnp.sqrt(-jnp.expm1(2.0 * log_a)) * (i * x32)

    def combine(left, right):
        a_l, b_l = left
        a_r, b_r = right
        return a_l * a_r, a_r * b_l + b_r

    _, h = lax.associative_scan(combine, (a, u), axis=1)
    return h.astype(x.dtype)


def _split_qkv(t, n_heads, head_dim):
    bsz, slen, _ = t.shape
    t = t.reshape(bsz, slen, 3, n_heads, head_dim).transpose(2, 0, 3, 1, 4)
    return t[0], t[1], t[2]


def _merge_heads(o):
    bsz, nh, slen, hd = o.shape
    return o.transpose(0, 2, 1, 3).reshape(bsz, slen, nh * hd)


def _stick_breaking_attention(q, k, v):
    slen, hd = q.shape[2], q.shape[3]
    scale = hd ** -0.5
    outs = []
    for blk in range(slen // Q_BLOCK):
        q0, q1 = blk * Q_BLOCK, (blk + 1) * Q_BLOCK
        z = jnp.einsum('bhqd,bhkd->bhqk', q[:, :, q0:q1], k[:, :, :q1],
                       preferred_element_type=jnp.float32) * scale
        t_idx = q0 + jnp.arange(Q_BLOCK)[:, None]
        s_idx = jnp.arange(q1)[None, :]
        strict = s_idx < t_idx
        log_keep = jnp.where(strict, jax.nn.log_sigmoid(-z), 0.0)
        suffix = lax.cumsum(log_keep, axis=3, reverse=True) - log_keep
        w = jnp.where(strict, jnp.exp(jax.nn.log_sigmoid(z) + suffix), 0.0)
        outs.append(jnp.einsum('bhqk,bhkd->bhqd', w.astype(v.dtype), v[:, :, :q1]))
    return jnp.concatenate(outs, axis=2)


def _forgetting_attention(q, k, v, log_f):
    slen, hd = q.shape[2], q.shape[3]
    scale = hd ** -0.5
    cum = lax.cumsum(log_f, axis=2)
    outs = []
    for blk in range(slen // Q_BLOCK):
        q0, q1 = blk * Q_BLOCK, (blk + 1) * Q_BLOCK
        z = jnp.einsum('bhqd,bhkd->bhqk', q[:, :, q0:q1], k[:, :, :q1],
                       preferred_element_type=jnp.float32) * scale
        z = z + cum[:, :, q0:q1, None] - cum[:, :, None, :q1]
        causal = jnp.arange(q1)[None, :] <= (q0 + jnp.arange(Q_BLOCK)[:, None])
        p = jax.nn.softmax(jnp.where(causal, z, -jnp.inf), axis=-1)
        outs.append(jnp.einsum('bhqk,bhkd->bhqd', p.astype(v.dtype), v[:, :, :q1]))
    return jnp.concatenate(outs, axis=2)


def _hybrid_mixer(h, w_in, conv_w, conv_b, rg_wa, rg_ba, rg_wx, rg_bx, rg_lam, fox_bf, merge_b,
                  w_rg, w_sb, w_fox, w_o):
    bsz, slen, _ = h.shape
    proj = h @ w_in
    cuts = np.cumsum(IN_SIZES)[:-1].tolist()
    rg_x, rg_gate, sb_qkv, fox_qkv, fox_f, merge = jnp.split(proj, cuts, axis=-1)
    xa = _causal_depthwise_conv(rg_x, conv_w, conv_b)
    ya = jax.nn.gelu(rg_gate) * _rg_lru(xa, rg_wa, rg_ba, rg_wx, rg_bx, rg_lam)
    q_b, k_b, v_b = _split_qkv(sb_qkv, SB_HEADS, SB_HEAD_DIM)
    yb = _merge_heads(_stick_breaking_attention(q_b, k_b, v_b))
    q_c, k_c, v_c = _split_qkv(fox_qkv, FOX_HEADS, FOX_HEAD_DIM)
    log_f = jax.nn.log_sigmoid((fox_f + fox_bf).astype(jnp.float32)).transpose(0, 2, 1)
    yc = _merge_heads(_forgetting_attention(q_c, k_c, v_c, log_f))
    g = jax.nn.sigmoid(merge + merge_b).reshape(bsz, slen, N_BRANCHES, D_MODEL)
    mixed = g[:, :, 0] * (ya @ w_rg) + g[:, :, 1] * (yb @ w_sb) + g[:, :, 2] * (yc @ w_fox)
    return mixed @ w_o


def setup_inputs(seed: int = 0) -> dict:
    key = jax.random.key(seed)
    ks = jax.random.split(key, 32)
    f32 = jnp.float32
    L, D = DEPTH, D_MODEL

    def nrm(k, shape, fan_in, mult=1.0):
        return jax.random.normal(k, shape, f32) * (mult * fan_in ** -0.5)

    def gain(k, shape):
        return 1.0 + 0.01 * jax.random.normal(k, shape, f32)

    def small(k, shape):
        return 0.01 * jax.random.normal(k, shape, f32)

    a_c = jax.random.uniform(ks[12], (L, RG_WIDTH), f32, 0.9, 0.999)
    a = a_c ** (1.0 / RG_C)
    rg_lam = jnp.log(a) - jnp.log1p(-a)
    return {
        "x": jax.random.normal(ks[0], (BATCH, SEQ, D), f32),
        "c": jax.random.normal(ks[1], (BATCH, D), f32),
        "ffn1_norm": gain(ks[2], (L, D)),
        "ffn1_w1": nrm(ks[3], (L, D, D_FF), D),
        "ffn1_w3": nrm(ks[4], (L, D, D_FF), D),
        "ffn1_w2": nrm(ks[5], (L, D_FF, D), D_FF),
        "mix_norm": gain(ks[6], (L, D)),
        "w_in": nrm(ks[7], (L, D, N_IN), D),
        "conv_w": nrm(ks[8], (L, CONV_WIDTH, RG_WIDTH), CONV_WIDTH),
        "conv_b": small(ks[9], (L, RG_WIDTH)),
        "rg_wa": nrm(ks[10], (L, RG_BLOCKS, RG_BLOCK_DIM, RG_BLOCK_DIM), RG_BLOCK_DIM),
        "rg_ba": small(ks[11], (L, RG_WIDTH)),
        "rg_wx": nrm(ks[13], (L, RG_BLOCKS, RG_BLOCK_DIM, RG_BLOCK_DIM), RG_BLOCK_DIM),
        "rg_bx": small(ks[14], (L, RG_WIDTH)),
        "rg_lam": rg_lam,
        "fox_bf": jax.random.uniform(ks[15], (L, FOX_HEADS), f32, 2.0, 5.0),
        "merge_b": small(ks[16], (L, N_BRANCHES * D)),
        "w_rg": nrm(ks[17], (L, RG_WIDTH, D), RG_WIDTH),
        "w_sb": nrm(ks[18], (L, SB_WIDTH, D), SB_WIDTH),
        "w_fox": nrm(ks[19], (L, FOX_WIDTH, D), FOX_WIDTH),
        "w_o": nrm(ks[20], (L, D, D), D),
        "ffn2_norm": gain(ks[21], (L, D)),
        "ffn2_w1": nrm(ks[22], (L, D, D_FF), D),
        "ffn2_w3": nrm(ks[23], (L, D, D_FF), D),
        "ffn2_w2": nrm(ks[24], (L, D_FF, D), D_FF),
        "ada_w": nrm(ks[25], (L, D, N_SUBLAYERS * 3 * D), D, 0.1),
        "ada_b": small(ks[26], (L, N_SUBLAYERS * 3 * D)),
        "final_norm": gain(ks[27], (D,)),
        "final_ada_w": nrm(ks[28], (D, 2 * D), D, 0.1),
        "final_ada_b": small(ks[29], (2 * D,)),
    }


def reference(x, c, ffn1_norm, ffn1_w1, ffn1_w3, ffn1_w2, mix_norm, w_in, conv_w, conv_b,
              rg_wa, rg_ba, rg_wx, rg_bx, rg_lam, fox_bf, merge_b, w_rg, w_sb, w_fox, w_o,
              ffn2_norm, ffn2_w1, ffn2_w3, ffn2_w2, ada_w, ada_b, final_norm, final_ada_w,
              final_ada_b):
    bsz = x.shape[0]
    c_act = jax.nn.silu(c)
    for l in range(DEPTH):
        mod = (c_act @ ada_w[l] + ada_b[l]).reshape(bsz, N_SUBLAYERS, 3, D_MODEL)
        h = _modulate(_rmsnorm(x, ffn1_norm[l]), mod[:, 0, 0], mod[:, 0, 1])
        x = x + 0.5 * (1.0 + mod[:, 0, 2])[:, None, :] * _swiglu(h, ffn1_w1[l], ffn1_w3[l], ffn1_w2[l])
        h = _modulate(_rmsnorm(x, mix_norm[l]), mod[:, 1, 0], mod[:, 1, 1])
        y = _hybrid_mixer(h, w_in[l], conv_w[l], conv_b[l], rg_wa[l], rg_ba[l], rg_wx[l], rg_bx[l],
                          rg_lam[l], fox_bf[l], merge_b[l], w_rg[l], w_sb[l], w_fox[l], w_o[l])
        x = x + (1.0 + mod[:, 1, 2])[:, None, :] * y
        h = _modulate(_rmsnorm(x, ffn2_norm[l]), mod[:, 2, 0], mod[:, 2, 1])
        x = x + 0.5 * (1.0 + mod[:, 2, 2])[:, None, :] * _swiglu(h, ffn2_w1[l], ffn2_w3[l], ffn2_w2[l])
    fm = (c_act @ final_ada_w + final_ada_b).reshape(bsz, 2, D_MODEL)
    return _modulate(_rmsnorm(x, final_norm), fm[:, 0], fm[:, 1])
```

```cpp
#include <hip/hip_runtime.h>
#include <hip/hip_cooperative_groups.h>
#include <cstdio>
#include <cstdint>
namespace cg = cooperative_groups;
#ifndef SKIPM
#define SKIPM 0
#endif
#define RUN(bit) (fwd != 0 || !((SKIPM) >> (bit) & 1))
#ifndef REPM
#define REPM 0
#endif
#define REP(bit) (((REPM) >> (bit)) & 1)

#define LAS __attribute__((address_space(3)))
#define DI __device__ __forceinline__
typedef unsigned short bf16_t;
typedef short bf16x8 __attribute__((ext_vector_type(8)));
typedef short s16x4 __attribute__((ext_vector_type(4)));
typedef float f32x4 __attribute__((ext_vector_type(4)));
typedef float f32x16 __attribute__((ext_vector_type(16)));
typedef unsigned u32x4 __attribute__((ext_vector_type(4)));
typedef unsigned u32x2 __attribute__((ext_vector_type(2)));

constexpr int NB = 16, SEQ = 2048, DM = 1024, DFF = 2816, M = NB * SEQ, PP = 5120  , NADA = 9216;
constexpr int NWAVES = 8, NTHR = 512;
constexpr float EPS = 1e-6f;
constexpr float LOG2E = 1.4426950408889634f;
constexpr float C2 = 0.125f * LOG2E;
constexpr size_t MiB = 1u << 20;
constexpr size_t WS_MOD = 1 * MiB;
constexpr size_t WS_FM = WS_MOD + (size_t)2 * NB * NADA * 4;
constexpr size_t WS_LOGF = 3 * MiB;
constexpr size_t WS_GSCR = 4 * MiB;
constexpr size_t WS_WUP1 = 36 * MiB;
constexpr size_t WS_WDN1 = 47 * MiB;
constexpr size_t WS_WUP2 = 53 * MiB;
constexpr size_t WS_WDN2 = 64 * MiB;
constexpr size_t WS_WIN = 70 * MiB;
constexpr size_t WS_WG = 80 * MiB;
constexpr size_t WS_WM = 86 * MiB;
constexpr size_t WS_WO = 90 * MiB;
constexpr size_t WS_XB = 92 * MiB;
constexpr size_t WS_DLAST = 332 * MiB;
constexpr size_t WS_PROJ = 156 * MiB;
constexpr size_t WS_HID = 156 * MiB;
constexpr size_t WS_END = 476 * MiB;
constexpr int LDS_BYTES = 147456;

struct Params { const float* in[30]; float* out; unsigned char* ws; };
typedef const __attribute__((address_space(4))) Params* KP;
__device__ __forceinline__ KP kparams() { KP q = (KP)__builtin_amdgcn_kernarg_segment_ptr(); asm volatile("" : "+s"(q)); return q; }

DI unsigned cvtpk(float lo, float hi) { typedef float f2 __attribute__((ext_vector_type(2))); typedef __bf16 b2 __attribute__((ext_vector_type(2))); f2 v = {lo, hi}; b2 b = __builtin_convertvector(v, b2); return __builtin_bit_cast(unsigned, b); }
DI float bf_lo(unsigned w) { return __uint_as_float(w << 16); }
DI float bf_hi(unsigned w) { return __uint_as_float(w & 0xffff0000u); }
DI float bf1(bf16_t v) { return __uint_as_float(((unsigned)v) << 16); }
DI bf16_t f2bf(float f) { return (bf16_t)(cvtpk(f, 0.f) & 0xffffu); }
DI float fexp2(float x) { return __builtin_amdgcn_exp2f(x); }
DI float flog2(float x) { return __builtin_amdgcn_logf(x); }
DI float frcp(float x) { return __builtin_amdgcn_rcpf(x); }
DI float sigmoidf(float v) { return frcp(1.f + fexp2(-v * LOG2E)); }
DI int opaque_tid() { int t = threadIdx.x; asm volatile("" : "+v"(t)); return t; }
DI float wave_sum(float v) {
#pragma unroll
    for (int o = 1; o < 64; o <<= 1) v += __shfl_xor(v, o);
    return v;
}
#define MFMA32(a, b, c) __builtin_amdgcn_mfma_f32_32x32x16_bf16((a), (b), (c), 0, 0, 0)
#define MFMA16(a, b, c) __builtin_amdgcn_mfma_f32_16x16x32_bf16((a), (b), (c), 0, 0, 0)

namespace pg8 {
constexpr int BM = 256, BK = 64, HALF = 128, HTB = HALF * BK * 2, STAGE_BYTES = 8 * HTB, NXCD = 8, WGM = 8;
DI int lds_byte(int r, int c) { const int st = (r >> 4) * 2 + (c >> 5), rr = r & 15, cc = c & 31, ob = rr * 64 + cc * 2; return st * 1024 + (ob ^ (((ob >> 9) & 1) << 5)); }
DI void stage_rc(int b, int& R, int& C) { const int st = b / 1024, sb = b % 1024, swz = sb ^ (((sb >> 9) & 1) << 5); R = (st >> 1) * 16 + swz / 64; C = (st & 1) * 32 + (swz % 64) / 2; }
DI int perm32(int rho) { const int n = rho >> 4, i = rho & 15; return 8 * (i >> 2) + 4 * n + (i & 3); }

enum { MODE_SWIGLU = 0, MODE_RESID = 1, MODE_PROJ = 2, MODE_GATE = 3, MODE_BRANCH = 4 };
struct Unit { const char* A; const char* B; unsigned lda, ldb; int nt, mode, pm, pn, aux; };
struct EpiCtx { bf16_t* hid; bf16_t* proj; bf16_t* hbuf; const float* mod; const float* merge_b; bf16_t* gscr; int dry; };

DI void tile_of(int L, int nM, int nN, int& pm, int& pn) {
    const int nwg = nM * nN; int wgid = L;
    { const int q = nwg / NXCD, r = nwg % NXCD, xcd = wgid % NXCD, off = wgid / NXCD; wgid = (xcd < r ? xcd * (q + 1) : r * (q + 1) + (xcd - r) * q) + off; }
    const int nig = WGM * nN, gid = wgid / nig, fm = gid * WGM, gsz = (nM - fm) < WGM ? (nM - fm) : WGM;
    pm = fm + ((wgid % nig) % gsz); pn = (wgid % nig) / gsz;
}

struct Sched {
    int kind, G, c, sub;
    const char *A0, *B0, *A1, *B1;
    DI bool next(int i, Unit& u) const {
        if (kind == 0) { const long L = (long)i * G + c; if (L >= 128 * 22) return false; tile_of((int)L, 128, 22, u.pm, u.pn);
            u.lda = 2048u; u.ldb = 2048u; u.A = A0 + (size_t)u.pm * 256 * 2048; u.B = B0 + (size_t)u.pn * 256 * 2048; u.nt = 16; u.mode = MODE_SWIGLU; u.aux = 0; return true; }
        if (kind == 1) { const long L = (long)i * G + c; if (L >= 128 * 4) return false; tile_of((int)L, 128, 4, u.pm, u.pn);
            u.lda = 5632u; u.ldb = 5632u; u.A = A0 + (size_t)u.pm * 256 * 5632; u.B = B0 + (size_t)u.pn * 256 * 5632; u.nt = 44; u.mode = MODE_RESID; u.aux = sub; return true; }
        if (kind == 2) { const long L = (long)i * G + c; if (L >= 128 * 20) return false; tile_of((int)L, 128, 20, u.pm, u.pn);
            u.lda = 2048u; u.ldb = 2048u; u.A = A0 + (size_t)u.pm * 256 * 2048; u.B = B0 + (size_t)u.pn * 256 * 2048; u.nt = 16; u.mode = MODE_PROJ; u.aux = 0; return true; }
        if (kind == 3) { if (i != 0) return false; tile_of(c, 128, 4, u.pm, u.pn); const int j = sub; u.aux = j;
            u.lda = 2048u; u.ldb = 2048u; u.A = A0 + (size_t)u.pm * 256 * 2048; u.B = B0 + (size_t)(j * 1024 + u.pn * 256) * 2048; u.nt = 16; u.mode = MODE_GATE; return true; }
        if (kind == 5) { if (i != 0) return false; tile_of(c, 128, 4, u.pm, u.pn); const int j = sub; u.aux = j;
            const int acol = (j == 0) ? 1024 : (j == 1 ? 2048 : 3584), kcol = (j == 0) ? 0 : (j == 1 ? 1024 : 1536);
            u.lda = PP * 2u; u.ldb = 4096u; u.A = A0 + (size_t)u.pm * 256 * (PP * 2) + acol * 2; u.B = B0 + (size_t)u.pn * 256 * 4096 + kcol * 2; u.nt = (j == 0) ? 16 : 8; u.mode = MODE_BRANCH; return true; }
        { const long L = (long)i * G + c; if (L >= 128 * 4) return false; tile_of((int)L, 128, 4, u.pm, u.pn);
            u.lda = PP * 2u; u.ldb = 2048u; u.A = A0 + (size_t)u.pm * 256 * (PP * 2); u.B = B0 + (size_t)u.pn * 256 * 2048; u.nt = 16; u.mode = MODE_RESID; u.aux = 1; return true; }
    }
};

DI void epilogue(const f32x4 (&acc)[2][2][4][2], const Unit& u, const EpiCtx& E, int tid, int wr, int wc, int fr, int fq) {
    const int row0 = u.pm * BM + wr * 64 + fr, colw = wc * 32 + 8 * fq;
    if (u.mode == MODE_SWIGLU) {
#pragma unroll
        for (int ai = 0; ai < 2; ++ai)
#pragma unroll
            for (int m = 0; m < 4; ++m) {
                bf16_t* rowp = E.hid + (size_t)(row0 + ai * HALF + m * 16) * DFF + u.pn * 128 + colw;
                float o[8];
#pragma unroll
                for (int n = 0; n < 2; ++n)
#pragma unroll
                    for (int e = 0; e < 4; ++e) { const float a = acc[ai][0][m][n][e], g = acc[ai][1][m][n][e]; o[4 * n + e] = a * sigmoidf(a) * g; }
                u32x4 w; w.x = cvtpk(o[0], o[1]); w.y = cvtpk(o[2], o[3]); w.z = cvtpk(o[4], o[5]); w.w = cvtpk(o[6], o[7]);
                *(u32x4*)rowp = w;
            }
    } else if (u.mode == MODE_RESID) {
#pragma unroll
        for (int ai = 0; ai < 2; ++ai)
#pragma unroll
            for (int m = 0; m < 4; ++m) {
                bf16_t* rowp = E.hbuf + (size_t)(row0 + ai * HALF + m * 16) * DM + u.pn * BM + colw;
#pragma unroll
                for (int bj = 0; bj < 2; ++bj) { const f32x4 v0 = acc[ai][bj][m][0], v1 = acc[ai][bj][m][1];
                    u32x4 w; w.x = cvtpk(v0[0], v0[1]); w.y = cvtpk(v0[2], v0[3]); w.z = cvtpk(v1[0], v1[1]); w.w = cvtpk(v1[2], v1[3]);
                    *(u32x4*)(rowp + bj * HALF) = w; }
            }
    } else if (u.mode == MODE_PROJ) {
        const float sc = (u.pn == 8 || u.pn == 9 || u.pn == 14 || u.pn == 15) ? C2 : 1.0f;
#pragma unroll
        for (int ai = 0; ai < 2; ++ai)
#pragma unroll
            for (int m = 0; m < 4; ++m) {
                bf16_t* rowp = E.proj + (size_t)(row0 + ai * HALF + m * 16) * PP + u.pn * BM + colw;
#pragma unroll
                for (int bj = 0; bj < 2; ++bj) { const f32x4 v0 = acc[ai][bj][m][0] * sc, v1 = acc[ai][bj][m][1] * sc;
                    u32x4 w; w.x = cvtpk(v0[0], v0[1]); w.y = cvtpk(v0[2], v0[3]); w.z = cvtpk(v1[0], v1[1]); w.w = cvtpk(v1[2], v1[3]);
                    *(u32x4*)(rowp + bj * HALF) = w; }
            }
    } else if (u.mode == MODE_GATE) {
        const float* bp = E.merge_b + u.aux * 1024 + u.pn * BM + colw;
        f32x4 bv[2][2];
#pragma unroll
        for (int bj = 0; bj < 2; ++bj)
#pragma unroll
            for (int n = 0; n < 2; ++n) bv[bj][n] = *(const f32x4*)(bp + bj * HALF + 4 * n);
#pragma unroll
        for (int ai = 0; ai < 2; ++ai)
#pragma unroll
            for (int m = 0; m < 4; ++m)
#pragma unroll
                for (int bj = 0; bj < 2; ++bj) { float o[8];
#pragma unroll
                    for (int n = 0; n < 2; ++n)
#pragma unroll
                        for (int e = 0; e < 4; ++e) o[4 * n + e] = sigmoidf(acc[ai][bj][m][n][e] + bv[bj][n][e]);
                    u32x4 w; w.x = cvtpk(o[0], o[1]); w.y = cvtpk(o[2], o[3]); w.z = cvtpk(o[4], o[5]); w.w = cvtpk(o[6], o[7]);
                    *(u32x4*)(E.gscr + ((size_t)(((ai * 4 + m) * 2 + bj) * NTHR) + tid) * 8) = w; }
    } else {
        const float dm = (E.dry && u.aux != 0) ? 0.0f : 1.0f;
#pragma unroll
        for (int ai = 0; ai < 2; ++ai)
#pragma unroll
            for (int m = 0; m < 4; ++m) {
                bf16_t* rowp = E.proj + (size_t)(row0 + ai * HALF + m * 16) * PP + u.pn * BM + colw;
#pragma unroll
                for (int bj = 0; bj < 2; ++bj) {
                    const u32x4 g = *(const u32x4*)(E.gscr + ((size_t)(((ai * 4 + m) * 2 + bj) * NTHR) + tid) * 8);
                    float o[8];
                    o[0] = dm * bf_lo(g.x) * acc[ai][bj][m][0][0]; o[1] = dm * bf_hi(g.x) * acc[ai][bj][m][0][1]; o[2] = dm * bf_lo(g.y) * acc[ai][bj][m][0][2]; o[3] = dm * bf_hi(g.y) * acc[ai][bj][m][0][3];
                    o[4] = dm * bf_lo(g.z) * acc[ai][bj][m][1][0]; o[5] = dm * bf_hi(g.z) * acc[ai][bj][m][1][1]; o[6] = dm * bf_lo(g.w) * acc[ai][bj][m][1][2]; o[7] = dm * bf_hi(g.w) * acc[ai][bj][m][1][3];
                    if (u.aux != 0) { const u32x4 q = *(const u32x4*)(rowp + bj * HALF);
                        o[0] += bf_lo(q.x); o[1] += bf_hi(q.x); o[2] += bf_lo(q.y); o[3] += bf_hi(q.y); o[4] += bf_lo(q.z); o[5] += bf_hi(q.z); o[6] += bf_lo(q.w); o[7] += bf_hi(q.w); }
                    u32x4 w; w.x = cvtpk(o[0], o[1]); w.y = cvtpk(o[2], o[3]); w.z = cvtpk(o[4], o[5]); w.w = cvtpk(o[6], o[7]);
                    *(u32x4*)(rowp + bj * HALF) = w; }
                asm volatile("" ::: "memory");
            }
    }
}

DI void gemm_phase(LAS unsigned char* lds, const Sched& S, const EpiCtx& E) {
    const int tid = opaque_tid(), wid = __builtin_amdgcn_readfirstlane(tid >> 6), lane = tid & 63, wr = wid >> 2, wc = wid & 3, fr = lane & 15, fq = lane >> 4;
    int R0, C0; stage_rc(tid * 16, R0, C0);
    const int Rb0 = (R0 & ~31) + perm32(R0 & 31);
    const size_t kstep = (size_t)(BK * 2);
    const unsigned ldsw = (unsigned)wid * 1024u;
    const int aoff = lds_byte(wr * 64 + fr, fq * 8), boff = lds_byte(wc * 32 + fr, fq * 8);
#define PG8_SA(b, h) (((b) * 2 + (h)) * HTB)
#define PG8_SB(b, h) ((4 + (b) * 2 + (h)) * HTB)
#define PG8_STAGE(bufoff, gbase, v0, ld) do { \
        __builtin_amdgcn_global_load_lds((const unsigned*)((const char*)(gbase) + (v0)), (LAS unsigned*)(lds + (bufoff) + ldsw), 16, 0, 0); \
        __builtin_amdgcn_global_load_lds((const unsigned*)((const char*)(gbase) + (size_t)(ld) * 64 + (v0)), (LAS unsigned*)(lds + (bufoff) + ldsw + 8192), 16, 0, 0); } while (0)
#define PG8_LDA(dst, b, h) do { _Pragma("unroll") for (int m = 0; m < 4; ++m) _Pragma("unroll") for (int k = 0; k < 2; ++k) dst[m][k] = *(const LAS bf16x8*)(lds + PG8_SA(b, h) + aoff + m * 2048 + k * 1024); } while (0)
#define PG8_LDB(dst, b, h) do { _Pragma("unroll") for (int n = 0; n < 2; ++n) _Pragma("unroll") for (int k = 0; k < 2; ++k) dst[n][k] = *(const LAS bf16x8*)(lds + PG8_SB(b, h) + boff + n * 2048 + k * 1024); } while (0)
#define PG8_MMA(ai, bj, At, Bt) do { __builtin_amdgcn_s_setprio(1); _Pragma("unroll") for (int m = 0; m < 4; ++m) _Pragma("unroll") for (int n = 0; n < 2; ++n) _Pragma("unroll") for (int k = 0; k < 2; ++k) \
        acc[ai][bj][m][n] = __builtin_amdgcn_mfma_f32_16x16x32_bf16(Bt[n][k], At[m][k], acc[ai][bj][m][n], 0, 0, 0); __builtin_amdgcn_s_setprio(0); } while (0)
#define PG8_WAIT_V(n) asm volatile("s_waitcnt vmcnt(" #n ")" ::: "memory")
#define PG8_WAIT_L(n) asm volatile("s_waitcnt lgkmcnt(" #n ")" ::: "memory")
#define PG8_BAR __builtin_amdgcn_s_barrier()
#define PG8_SCHED __builtin_amdgcn_sched_barrier(0)
    Unit cur, nxt; int ui = 0;
    if (!S.next(0, cur)) return;
    f32x4 acc[2][2][4][2];
#pragma unroll
    for (int a = 0; a < 2; ++a)
#pragma unroll
        for (int b = 0; b < 2; ++b)
#pragma unroll
            for (int m = 0; m < 4; ++m)
#pragma unroll
                for (int n = 0; n < 2; ++n) acc[a][b][m][n] = (f32x4){0.f, 0.f, 0.f, 0.f};
    bf16x8 At[4][2], B0[2][2], B1[2][2];
    const char* cA = cur.A; const char* cB = cur.B;
    unsigned vA0 = (unsigned)R0 * cur.lda + (unsigned)C0 * 2u, vB0 = (unsigned)Rb0 * cur.ldb + (unsigned)C0 * 2u;
    unsigned lA = cur.lda, lB = cur.ldb;
    size_t hA = (size_t)HALF * cur.lda, hB = (size_t)HALF * cur.ldb;
    PG8_STAGE(PG8_SB(0, 0), cB, vB0, lB); PG8_STAGE(PG8_SB(0, 1), cB + hB, vB0, lB); PG8_STAGE(PG8_SA(0, 0), cA, vA0, lA); PG8_STAGE(PG8_SA(0, 1), cA + hA, vA0, lA);
    if (wr == 1) PG8_BAR;
    PG8_WAIT_V(2); PG8_BAR;
    PG8_STAGE(PG8_SB(1, 0), cB + kstep, vB0, lB); PG8_STAGE(PG8_SA(1, 0), cA + kstep, vA0, lA); PG8_STAGE(PG8_SB(1, 1), cB + hB + kstep, vB0, lB);
    PG8_WAIT_V(6); PG8_BAR;
    for (;;) {
        const bool has_next = S.next(ui + 1, nxt);
        const char* nA = has_next ? nxt.A : cA; const char* nB = has_next ? nxt.B : cB;
        const unsigned nlda = has_next ? nxt.lda : cur.lda, nldb = has_next ? nxt.ldb : cur.ldb;
        const unsigned nvA0 = (unsigned)R0 * nlda + (unsigned)C0 * 2u, nvB0 = (unsigned)Rb0 * nldb + (unsigned)C0 * 2u;
        const size_t nhA = (size_t)HALF * nlda, nhB = (size_t)HALF * nldb;
        const int nt = cur.nt;
        for (int t = 0; t < nt; t += 2) {
            const bool last = (t == nt - 2);
            const char* a1 = cA + (size_t)(t + 1) * kstep;
            const char* a2 = last ? nA : cA + (size_t)(t + 2) * kstep; const char* b2 = last ? nB : cB + (size_t)(t + 2) * kstep;
            const char* a3 = a2 + kstep; const char* b3 = b2 + kstep;
            const unsigned xA0 = last ? nvA0 : vA0, xB0 = last ? nvB0 : vB0, xlA = last ? nlda : lA, xlB = last ? nldb : lB;
            const size_t xhA = last ? nhA : hA, xhB = last ? nhB : hB;
            PG8_LDB(B0, 0, 0); PG8_LDB(B1, 0, 1); PG8_SCHED; PG8_LDA(At, 0, 0); PG8_STAGE(PG8_SA(1, 1), a1 + hA, vA0, lA);
            PG8_WAIT_V(8); PG8_WAIT_L(0); PG8_BAR; PG8_MMA(0, 0, At, B0); PG8_MMA(0, 1, At, B1); PG8_BAR; PG8_SCHED;
            PG8_LDA(At, 0, 1); PG8_STAGE(PG8_SB(0, 0), b2, xB0, xlB); PG8_STAGE(PG8_SB(0, 1), b2 + xhB, xB0, xlB); PG8_STAGE(PG8_SA(0, 0), a2, xA0, xlA);
            PG8_WAIT_V(8); PG8_WAIT_L(0); PG8_BAR; PG8_MMA(1, 0, At, B0); PG8_MMA(1, 1, At, B1); PG8_BAR; PG8_SCHED;
            PG8_LDB(B0, 1, 0); PG8_LDB(B1, 1, 1); PG8_SCHED; PG8_LDA(At, 1, 0); PG8_STAGE(PG8_SA(0, 1), a2 + xhA, xA0, xlA);
            PG8_WAIT_V(8); PG8_WAIT_L(0); PG8_BAR; PG8_MMA(0, 0, At, B0); PG8_MMA(0, 1, At, B1); PG8_BAR; PG8_SCHED;
            PG8_LDA(At, 1, 1); PG8_STAGE(PG8_SB(1, 0), b3, xB0, xlB); PG8_STAGE(PG8_SB(1, 1), b3 + xhB, xB0, xlB); PG8_STAGE(PG8_SA(1, 0), a3, xA0, xlA);
            PG8_WAIT_V(8); PG8_WAIT_L(0); PG8_BAR; PG8_MMA(1, 0, At, B0); PG8_MMA(1, 1, At, B1); PG8_BAR; PG8_SCHED;
        }
        if (wr == 0) PG8_BAR;
        epilogue(acc, cur, E, tid, wr, wc, fr, fq);
        if (!has_next) break;
#pragma unroll
        for (int a = 0; a < 2; ++a)
#pragma unroll
            for (int b = 0; b < 2; ++b)
#pragma unroll
                for (int m = 0; m < 4; ++m)
#pragma unroll
                    for (int n = 0; n < 2; ++n) acc[a][b][m][n] = (f32x4){0.f, 0.f, 0.f, 0.f};
        cur = nxt; cA = nA; cB = nB; vA0 = nvA0; vB0 = nvB0; lA = nlda; lB = nldb; hA = nhA; hB = nhB; ++ui;
        if (wr == 1) PG8_BAR;
    }
    PG8_WAIT_V(0);
    PG8_BAR;
#undef PG8_SA
#undef PG8_SB
#undef PG8_STAGE
#undef PG8_LDA
#undef PG8_LDB
#undef PG8_MMA
#undef PG8_WAIT_V
#undef PG8_WAIT_L
#undef PG8_BAR
#undef PG8_SCHED
}
}

DI void tr_item(const float* src, int srcP, int srcCol, int k0, bf16_t* dst, int dstP, int dstRow, int dstK, LAS float* scr, int lane) {
    float tv[32];
#pragma unroll
    for (int i = 0; i < 32; ++i) { const int kk = 2 * i + (lane >> 5); tv[i] = __builtin_nontemporal_load(src + (size_t)(k0 + kk) * srcP + srcCol + (lane & 31)); }
#pragma unroll
    for (int i = 0; i < 32; ++i) { const int kk = 2 * i + (lane >> 5); scr[kk * 33 + (lane & 31)] = tv[i]; }
    asm volatile("s_waitcnt lgkmcnt(0)" ::: "memory");
    const int c = lane & 7;
#pragma unroll
    for (int j = 0; j < 4; ++j) { const int n = (lane >> 3) + 8 * j; const LAS float* s = scr + (8 * c) * 33 + n;
        u32x4 o; o.x = cvtpk(s[0 * 33], s[1 * 33]); o.y = cvtpk(s[2 * 33], s[3 * 33]); o.z = cvtpk(s[4 * 33], s[5 * 33]); o.w = cvtpk(s[6 * 33], s[7 * 33]);
        *(u32x4*)(dst + (size_t)(dstRow + n) * dstP + dstK + k0 + 8 * c) = o; }
    asm volatile("s_waitcnt lgkmcnt(0)" ::: "memory");
}
DI void tr_job(int r, const float* src, int srcP, int srcC, int N, bf16_t* dst, int dstP, int dstK, int upHalf, LAS float* scr, int lane) {
    const int nblk = N / 32, kb = r / nblk, nb = r - kb * nblk, n0 = nb * 32;
    const int dstRow = (upHalf >= 0) ? ((n0 >> 7) * 256 + upHalf * 128 + (n0 & 127)) : n0;
    tr_item(src, srcP, srcC + n0, kb * 64, dst, dstP, dstRow, dstK, scr, lane);
}
DI void convert_weights(int l, LAS unsigned char* lds, int gw, int ngw) {
    const KP p = kparams();
    const int lane = opaque_tid() & 63, wave = gw & 7;
    LAS float* scr = (LAS float*)(lds + wave * 16384);
    unsigned char* ws = p->ws;
    const float* w1a = p->in[3] + (size_t)l * DM * DFF; const float* w3a = p->in[4] + (size_t)l * DM * DFF; const float* w2a = p->in[5] + (size_t)l * DFF * DM;
    const float* w1b = p->in[22] + (size_t)l * DM * DFF; const float* w3b = p->in[23] + (size_t)l * DM * DFF; const float* w2b = p->in[24] + (size_t)l * DFF * DM;
    const float* win = p->in[7] + (size_t)l * DM * 8200;
    const float* wrg = p->in[17] + (size_t)l * 1024 * 1024; const float* wsb = p->in[18] + (size_t)l * 512 * 1024; const float* wfx = p->in[19] + (size_t)l * 512 * 1024;
    const float* wo = p->in[20] + (size_t)l * 1024 * 1024;
    constexpr int I_UP = 16 * 88, I_DN = 44 * 32, I_IN = 16 * 160, I_G = 16 * 96, I_RG = 16 * 32, I_SB = 8 * 32, I_O = 16 * 32;
    constexpr int NITEMS = 4 * I_UP + 2 * I_DN + I_IN + I_G + I_RG + 2 * I_SB + I_O;
    const int ipw = (NITEMS + ngw - 1) / ngw;
    for (int it = gw * ipw; it < (gw + 1) * ipw && it < NITEMS; ++it) {
        int r = it;
        if (r < I_UP) { tr_job(r, w1a, DFF, 0, DFF, (bf16_t*)(ws + WS_WUP1), 1024, 0, 0, scr, lane); continue; } r -= I_UP;
        if (r < I_UP) { tr_job(r, w3a, DFF, 0, DFF, (bf16_t*)(ws + WS_WUP1), 1024, 0, 1, scr, lane); continue; } r -= I_UP;
        if (r < I_DN) { tr_job(r, w2a, DM, 0, DM, (bf16_t*)(ws + WS_WDN1), DFF, 0, -1, scr, lane); continue; } r -= I_DN;
        if (r < I_UP) { tr_job(r, w1b, DFF, 0, DFF, (bf16_t*)(ws + WS_WUP2), 1024, 0, 0, scr, lane); continue; } r -= I_UP;
        if (r < I_UP) { tr_job(r, w3b, DFF, 0, DFF, (bf16_t*)(ws + WS_WUP2), 1024, 0, 1, scr, lane); continue; } r -= I_UP;
        if (r < I_DN) { tr_job(r, w2b, DM, 0, DM, (bf16_t*)(ws + WS_WDN2), DFF, 0, -1, scr, lane); continue; } r -= I_DN;
        if (r < I_IN) { tr_job(r, win, 8200, 0, 5120, (bf16_t*)(ws + WS_WIN), 1024, 0, -1, scr, lane); continue; } r -= I_IN;
        if (r < I_G) { tr_job(r, win, 8200, 5128, 3072, (bf16_t*)(ws + WS_WG), 1024, 0, -1, scr, lane); continue; } r -= I_G;
        if (r < I_RG) { tr_job(r, wrg, 1024, 0, 1024, (bf16_t*)(ws + WS_WM), 2048, 0, -1, scr, lane); continue; } r -= I_RG;
        if (r < I_SB) { tr_job(r, wsb, 1024, 0, 1024, (bf16_t*)(ws + WS_WM), 2048, 1024, -1, scr, lane); continue; } r -= I_SB;
        if (r < I_SB) { tr_job(r, wfx, 1024, 0, 1024, (bf16_t*)(ws + WS_WM), 2048, 1536, -1, scr, lane); continue; } r -= I_SB;
        tr_job(r, wo, 1024, 0, 1024, (bf16_t*)(ws + WS_WO), 1024, 0, -1, scr, lane);
    }
}

DI void ada_unit(int u, LAS unsigned char* lds) {
    const KP p = kparams();
    const int tid = opaque_tid();
    LAS float* cT = (LAS float*)lds;
    LAS float* red = (LAS float*)(lds + 65536);
    const float* c = p->in[1];
    for (int i = tid; i < NB * DM; i += NTHR) { const int b = i >> 10, k = i & 1023; const float v = c[i]; cT[k * 16 + b] = v * sigmoidf(v); }
    __syncthreads();
    const float* W; const float* bias; float* out; int pitch, j0;
    if (u < 144) { const int l = u / 72, uu = u - l * 72; j0 = uu * 128; pitch = NADA; W = p->in[25] + (size_t)l * DM * NADA; bias = p->in[26] + (size_t)l * NADA; out = (float*)(p->ws + WS_MOD) + (size_t)l * NB * NADA; }
    else { j0 = (u - 144) * 128; pitch = 2048; W = p->in[28]; bias = p->in[29]; out = (float*)(p->ws + WS_FM); }
    const int col = tid & 127, q = tid >> 7;
    float acc[16];
#pragma unroll
    for (int b = 0; b < 16; ++b) acc[b] = 0.f;
    const float* wp = W + (size_t)(q * 256) * pitch + j0 + col;
    for (int k0 = 0; k0 < 256; k0 += 16) {
        float wv[16];
#pragma unroll
        for (int kk = 0; kk < 16; ++kk) wv[kk] = __builtin_nontemporal_load(wp + (size_t)(k0 + kk) * pitch);
#pragma unroll
        for (int kk = 0; kk < 16; ++kk) {
            const float w = wv[kk];
            const LAS f32x4* cp = (const LAS f32x4*)(cT + (q * 256 + k0 + kk) * 16);
            const f32x4 c0 = cp[0], c1 = cp[1], c2 = cp[2], c3 = cp[3];
            acc[0] += c0[0] * w; acc[1] += c0[1] * w; acc[2] += c0[2] * w; acc[3] += c0[3] * w;
            acc[4] += c1[0] * w; acc[5] += c1[1] * w; acc[6] += c1[2] * w; acc[7] += c1[3] * w;
            acc[8] += c2[0] * w; acc[9] += c2[1] * w; acc[10] += c2[2] * w; acc[11] += c2[3] * w;
            acc[12] += c3[0] * w; acc[13] += c3[1] * w; acc[14] += c3[2] * w; acc[15] += c3[3] * w;
        }
    }
#pragma unroll
    for (int b = 0; b < 16; ++b) red[(q * 16 + b) * 128 + col] = acc[b];
    __syncthreads();
    for (int i = tid; i < 16 * 128; i += NTHR) { const int b = i >> 7, cc = i & 127;
        const float s = red[(0 * 16 + b) * 128 + cc] + red[(1 * 16 + b) * 128 + cc] + red[(2 * 16 + b) * 128 + cc] + red[(3 * 16 + b) * 128 + cc];
        out[(size_t)b * pitch + j0 + cc] = s + bias[j0 + cc]; }
    __syncthreads();
}

DI void norm_phase(int l, int mode, int sub, LAS unsigned char* lds, int gw, int ngw, int dsub = -1, int dl = 0) {
    const KP p = kparams();
    const int lane = opaque_tid() & 63;
    const float* xin = p->in[0];
    bf16_t* xb = (bf16_t*)(p->ws + WS_XB);
    const bf16_t* dsrc = (mode == 3) ? (const bf16_t*)(p->ws + WS_DLAST) : (const bf16_t*)p->out;
    const float* gain = (mode == 3) ? p->in[27] : ((sub == 0 ? p->in[2] : (sub == 1 ? p->in[6] : p->in[21])) + (size_t)l * DM);
    const float* mod = (mode == 3) ? (const float*)(p->ws + WS_FM) : ((const float*)(p->ws + WS_MOD) + (size_t)l * NB * NADA + sub * 3072);
    const int mpitch = (mode == 3) ? 2048 : NADA;
    bf16_t* hout = (bf16_t*)p->out;
    LAS float* wfT = (LAS float*)lds;
    if (mode == 2) {
        const float* win = p->in[7] + (size_t)l * DM * 8200 + 5120;
        for (int i = opaque_tid(); i < 8192; i += NTHR) { const int k = i >> 3, j = i & 7; wfT[j * 1024 + k] = win[(size_t)k * 8200 + j]; }
        __syncthreads();
    }
    f32x4 g[4];
#pragma unroll
    for (int j = 0; j < 4; ++j) g[j] = *(const f32x4*)(gain + 4 * lane + 256 * j);
    constexpr int RPW = 4;
    const int rows_per_wave = M / ngw;
    const int mw0 = gw * rows_per_wave, b = mw0 >> 11;
    f32x4 sh[4], sc[4], gt[4];
    {
        const float* mp = mod + (size_t)b * mpitch + 4 * lane;
        const float coef = (dsub == 1) ? 1.0f : 0.5f;
        const float* gp = (const float*)(p->ws + WS_MOD) + (size_t)dl * NB * NADA + (size_t)b * NADA + (dsub >= 0 ? dsub : 0) * 3072 + 2048 + 4 * lane;
        f32x4 t0[4], t1[4], t2[4];
#pragma unroll
        for (int j = 0; j < 4; ++j) { t0[j] = *(const f32x4*)(mp + 256 * j); t1[j] = *(const f32x4*)(mp + 1024 + 256 * j); t2[j] = *(const f32x4*)(gp + 256 * j); }
#pragma unroll
        for (int j = 0; j < 4; ++j) { sh[j] = t0[j]; sc[j] = (t1[j] + 1.0f) * g[j]; gt[j] = (t2[j] + 1.0f) * coef; }
    }
    for (int m0 = mw0; m0 < mw0 + rows_per_wave; m0 += RPW) {
        f32x4 v[RPW][4]; u32x2 dw[RPW][4];
        if (mode == 1) {
#pragma unroll
            for (int i = 0; i < RPW; ++i)
#pragma unroll
                for (int j = 0; j < 4; ++j) v[i][j] = *(const f32x4*)(xin + (size_t)(m0 + i) * DM + 4 * lane + 256 * j);
        } else {
#pragma unroll
            for (int i = 0; i < RPW; ++i)
#pragma unroll
                for (int j = 0; j < 4; ++j) { const u32x2 xw = __builtin_nontemporal_load((const u32x2*)(xb + (size_t)(m0 + i) * DM + 4 * lane + 256 * j)); v[i][j] = (f32x4){bf_lo(xw.x), bf_hi(xw.x), bf_lo(xw.y), bf_hi(xw.y)}; }
        }
        if (dsub >= 0) {
#pragma unroll
            for (int i = 0; i < RPW; ++i)
#pragma unroll
                for (int j = 0; j < 4; ++j) dw[i][j] = __builtin_nontemporal_load((const u32x2*)(dsrc + (size_t)(m0 + i) * DM + 4 * lane + 256 * j));
#pragma unroll
            for (int j = 0; j < 4; ++j)
#pragma unroll
                for (int i = 0; i < RPW; ++i) { v[i][j][0] += gt[j][0] * bf_lo(dw[i][j].x); v[i][j][1] += gt[j][1] * bf_hi(dw[i][j].x); v[i][j][2] += gt[j][2] * bf_lo(dw[i][j].y); v[i][j][3] += gt[j][3] * bf_hi(dw[i][j].y); }
        }
        float ss[RPW];
#pragma unroll
        for (int i = 0; i < RPW; ++i) { float t = 0.f;
#pragma unroll
            for (int j = 0; j < 4; ++j) t += (v[i][j][0] * v[i][j][0] + v[i][j][1] * v[i][j][1]) + (v[i][j][2] * v[i][j][2] + v[i][j][3] * v[i][j][3]);
            ss[i] = t; }
        if (mode == 1 || (dsub >= 0 && mode != 3)) {
#pragma unroll
            for (int i = 0; i < RPW; ++i)
#pragma unroll
                for (int j = 0; j < 4; ++j) { u32x2 w; w.x = cvtpk(v[i][j][0], v[i][j][1]); w.y = cvtpk(v[i][j][2], v[i][j][3]); __builtin_nontemporal_store(w, (u32x2*)(xb + (size_t)(m0 + i) * DM + 4 * lane + 256 * j)); }
        }
#pragma unroll
        for (int o = 1; o < 64; o <<= 1) {
#pragma unroll
            for (int i = 0; i < RPW; ++i) ss[i] += __shfl_xor(ss[i], o);
        }
#pragma unroll
        for (int i = 0; i < RPW; ++i) {
            const int m = m0 + i;
            const float r = 1.0f / sqrtf(ss[i] * (1.0f / DM) + EPS);
            f32x4 hv[4];
#pragma unroll
            for (int j = 0; j < 4; ++j) hv[j] = (v[i][j] * r) * sc[j] + sh[j];
            if (mode == 3) {
#pragma unroll
                for (int j = 0; j < 4; ++j) *(f32x4*)(p->out + (size_t)m * DM + 4 * lane + 256 * j) = hv[j];
            } else {
#pragma unroll
                for (int j = 0; j < 4; ++j) { u32x2 w; w.x = cvtpk(hv[j][0], hv[j][1]); w.y = cvtpk(hv[j][2], hv[j][3]); *(u32x2*)(hout + (size_t)m * DM + 4 * lane + 256 * j) = w; }
            }
            if (mode == 2) {
                float d[8];
                const LAS float* wq = wfT + 4 * lane; asm volatile("" : "+v"(wq));
#pragma unroll
                for (int jj = 0; jj < 8; ++jj) { float s = 0.f;
#pragma unroll
                    for (int j = 0; j < 4; ++j) { const f32x4 w = *(const LAS f32x4*)(wq + jj * 1024 + 256 * j); s += (hv[j][0] * w[0] + hv[j][1] * w[1]) + (hv[j][2] * w[2] + hv[j][3] * w[3]); }
                    d[jj] = s; }
#pragma unroll
                for (int o = 1; o < 64; o <<= 1) {
#pragma unroll
                    for (int jj = 0; jj < 8; ++jj) d[jj] += __shfl_xor(d[jj], o);
                }
                if (lane < 8) { float dv = d[0];
#pragma unroll
                    for (int jj = 1; jj < 8; ++jj) dv = (lane == jj) ? d[jj] : dv;
                    const float z = dv + p->in[15][l * 8 + lane];
                    const float ls = -(fmaxf(-z, 0.f) + log1pf(__expf(-fabsf(z))));
                    ((float*)(p->ws + WS_LOGF))[((size_t)b * 8 + lane) * SEQ + (m & (SEQ - 1))] = ls; }
            }
        }
    }
    if (mode == 2) __syncthreads();
}

constexpr int RG_TC = 128;
constexpr int RG_RGX = 0;
constexpr int RG_XAB = 16768;
constexpr int RG_WAT = RG_XAB + 18432;
constexpr int RG_WXT = RG_WAT + 9216;
constexpr int RG_AS = RG_WXT + 9216;
constexpr int RG_US = RG_AS + 34816;
constexpr int RG_CARRY = RG_US + 34816;
constexpr int RG_HST = RG_CARRY + 4096;
static_assert(RG_HST + 512 <= LDS_BYTES, "rg lds");

DI void rg_unit(int l, int b, int n, LAS unsigned char* lds, int dry = 0) {
    const KP p = kparams();
    const int tid = opaque_tid(), lane = tid & 63, wid = __builtin_amdgcn_readfirstlane(tid >> 6);
    bf16_t* proj = (bf16_t*)(p->ws + WS_PROJ);
    const int c0 = n * 64;
    const float* convw = p->in[8] + (size_t)l * 4 * 1024; const float* convb = p->in[9] + (size_t)l * 1024;
    const float* wa = p->in[10] + ((size_t)l * 16 + n) * 4096; const float* wx = p->in[12] + ((size_t)l * 16 + n) * 4096;
    const float* ba = p->in[11] + (size_t)l * 1024 + c0; const float* bx = p->in[13] + (size_t)l * 1024 + c0; const float* lam = p->in[14] + (size_t)l * 1024 + c0;
    LAS bf16_t* rgx = (LAS bf16_t*)(lds + RG_RGX); LAS bf16_t* xab = (LAS bf16_t*)(lds + RG_XAB);
    LAS bf16_t* wat = (LAS bf16_t*)(lds + RG_WAT); LAS bf16_t* wxt = (LAS bf16_t*)(lds + RG_WXT);
    LAS float* As = (LAS float*)(lds + RG_AS); LAS float* Us = (LAS float*)(lds + RG_US);
    LAS float* carry = (LAS float*)(lds + RG_CARRY); LAS float* hst = (LAS float*)(lds + RG_HST);
    const size_t rowbase = (size_t)b * SEQ;
    const int pr0 = tid >> 3, pc = tid & 7;
    const bf16_t* xsrc = proj + rowbase * PP + c0 + pc * 8;
    u32x4 x0, x1, x2;
    { const u32x4 z4 = (u32x4){0u, 0u, 0u, 0u};
      x0 = (pr0 - 3 >= 0) ? *(const u32x4*)(xsrc + (size_t)(pr0 - 3) * PP) : z4;
      x1 = *(const u32x4*)(xsrc + (size_t)(pr0 + 64 - 3) * PP);
      x2 = z4; if (tid < 24) x2 = *(const u32x4*)(xsrc + (size_t)(pr0 + 128 - 3) * PP); }
    for (int i = tid; i < 4096; i += NTHR) { const int d = i >> 6, e = i & 63; wat[e * 72 + d] = f2bf(wa[i]); wxt[e * 72 + d] = f2bf(wx[i]); }
    if (tid < 128) hst[tid] = 0.f;
    const float cw0 = convw[c0 + lane], cw1 = convw[1024 + c0 + lane], cw2 = convw[2048 + c0 + lane], cw3 = convw[3072 + c0 + lane], cbv = convb[c0 + lane];
    float bae[4], bxe[4], spe[4];
#pragma unroll
    for (int ei = 0; ei < 4; ++ei) { const int e = 16 * ei + (lane & 15); bae[ei] = ba[e]; bxe[ei] = bx[e]; const float lm = lam[e];
        spe[ei] = -8.0f * (fmaxf(-lm, 0.f) + log1pf(__expf(-fabsf(lm)))); }
    *(LAS u32x4*)(rgx + pr0 * 64 + pc * 8) = x0; *(LAS u32x4*)(rgx + (pr0 + 64) * 64 + pc * 8) = x1; if (tid < 24) *(LAS u32x4*)(rgx + (pr0 + 128) * 64 + pc * 8) = x2;
    __syncthreads();
#define LDS_BAR() do { asm volatile("s_waitcnt lgkmcnt(0)" ::: "memory"); __builtin_amdgcn_s_barrier(); asm volatile("" ::: "memory"); } while (0)
    for (int ch = 0; ch < SEQ / RG_TC; ++ch) {
        const int t0 = ch * RG_TC;
        bf16_t* gp = proj + (rowbase + t0 + 16 * wid) * PP + 1024 + c0 + lane;
        unsigned gq[16];
#pragma unroll
        for (int s2 = 0; s2 < 16; ++s2) gq[s2] = gp[(size_t)s2 * PP];
        const bool more = ch + 1 < SEQ / RG_TC;
        if (more) { const bf16_t* xs = xsrc + (size_t)(t0 + RG_TC - 3) * PP;
            x0 = *(const u32x4*)(xs + (size_t)pr0 * PP); x1 = *(const u32x4*)(xs + (size_t)(pr0 + 64) * PP); if (tid < 24) x2 = *(const u32x4*)(xs + (size_t)(pr0 + 128) * PP); }
#pragma unroll 4
        for (int i = 0; i < 16; ++i) { const int t = wid + 8 * i;
            const float v0 = bf1(rgx[(t + 0) * 64 + lane]), v1 = bf1(rgx[(t + 1) * 64 + lane]), v2 = bf1(rgx[(t + 2) * 64 + lane]), v3 = bf1(rgx[(t + 3) * 64 + lane]);
            const float xa = cbv + cw0 * v0 + cw1 * v1 + cw2 * v2 + cw3 * v3;
            Us[t * 68 + lane] = xa; xab[t * 72 + lane] = f2bf(xa); }
        LDS_BAR();
        {
            const int row = lane & 15, quad = lane >> 4;
            const bf16x8 a0 = *(const LAS bf16x8*)(xab + (16 * wid + row) * 72 + quad * 8), a1 = *(const LAS bf16x8*)(xab + (16 * wid + row) * 72 + 32 + quad * 8);
#pragma unroll
            for (int ei = 0; ei < 4; ++ei) {
                const bf16x8 ba0 = *(const LAS bf16x8*)(wat + (16 * ei + row) * 72 + quad * 8), ba1 = *(const LAS bf16x8*)(wat + (16 * ei + row) * 72 + 32 + quad * 8);
                const bf16x8 bx0 = *(const LAS bf16x8*)(wxt + (16 * ei + row) * 72 + quad * 8), bx1 = *(const LAS bf16x8*)(wxt + (16 * ei + row) * 72 + 32 + quad * 8);
                f32x4 rr = (f32x4){0.f, 0.f, 0.f, 0.f}, ii = (f32x4){0.f, 0.f, 0.f, 0.f};
                rr = MFMA16(a0, ba0, rr); rr = MFMA16(a1, ba1, rr);
                ii = MFMA16(a0, bx0, ii); ii = MFMA16(a1, bx1, ii);
#pragma unroll
                for (int jj = 0; jj < 4; ++jj) { const int t = 16 * wid + quad * 4 + jj, e = 16 * ei + row;
                    const float r = sigmoidf(rr[jj] + bae[ei]), ig = sigmoidf(ii[jj] + bxe[ei]);
                    const float la = r * spe[ei];
                    const float a = fexp2(la * LOG2E);
                    const float x2l = 2.0f * la;
                    const float ser = -x2l * (1.0f + x2l * (0.5f + x2l * (0.16666667f + x2l * (0.041666668f + x2l * (0.0083333338f + x2l * 0.0013888889f)))));
                    const float om = (x2l > -0.5f) ? ser : (1.0f - a * a);
                    const float sq = sqrtf(om);
                    const float xa = Us[t * 68 + e];
                    Us[t * 68 + e] = sq * ig * xa; As[t * 68 + e] = a; }
            }
        }
        LDS_BAR();
        {
            float P = 1.f, H = 0.f;
#pragma unroll
            for (int s2 = 0; s2 < 16; ++s2) { const int t = 16 * wid + s2; const float a = As[t * 68 + lane], u = Us[t * 68 + lane]; H = a * H + u; P *= a; }
            carry[(wid * 64 + lane) * 2] = P; carry[(wid * 64 + lane) * 2 + 1] = H;
            if (more) { *(LAS u32x4*)(rgx + pr0 * 64 + pc * 8) = x0; *(LAS u32x4*)(rgx + (pr0 + 64) * 64 + pc * 8) = x1; if (tid < 24) *(LAS u32x4*)(rgx + (pr0 + 128) * 64 + pc * 8) = x2; }
        }
        LDS_BAR();
        {
            float h = hst[(ch & 1) * 64 + lane];
            for (int s2 = 0; s2 < wid; ++s2) h = carry[(s2 * 64 + lane) * 2] * h + carry[(s2 * 64 + lane) * 2 + 1];
#pragma unroll
            for (int s2 = 0; s2 < 16; ++s2) { const int t = 16 * wid + s2; const float a = As[t * 68 + lane], u = Us[t * 68 + lane]; h = a * h + u;
                const float gx = bf1((bf16_t)gq[s2]);
                const float y2 = 1.5957691216f * (gx + 0.044715f * gx * gx * gx);
                const float ge = gx * sigmoidf(y2);
                if (!dry) gp[(size_t)s2 * PP] = f2bf(ge * h); }
            if (wid == 7) hst[((ch + 1) & 1) * 64 + lane] = h;
        }
        LDS_BAR();
    }
}
#undef LDS_BAR

constexpr int AT_K = 0, AT_V = 18432, AT_BIAS = 36864, AT_SCAN = AT_BIAS + 8192;
DI int crow(int r, int h) { return (r & 3) + 8 * (r >> 2) + 4 * h; }
DI s16x4 vtr(const LAS unsigned char* pp) { typedef short v4i16_t __attribute__((ext_vector_type(4))); return __builtin_bit_cast(s16x4, __builtin_amdgcn_ds_read_tr16_b64_v4i16((LAS v4i16_t*)pp)); }

struct AttnPre { bf16x8 q[4]; u32x4 k0, v0; f32x4 lf; };
DI void attn_prefetch(AttnPre& P, int sb, int b, int h, int qb) {
    const KP p = kparams();
    const int tid = opaque_tid(), lane = tid & 63, wid = __builtin_amdgcn_readfirstlane(tid >> 6), r32 = lane & 31, hi = lane >> 5;
    const bf16_t* proj = (const bf16_t*)(p->ws + WS_PROJ);
    const int colQ = (sb ? 2048 : 3584) + h * 64, colK = colQ + 512, colV = colQ + 1024;
    const size_t rowbase = (size_t)b * SEQ;
    const int qrow = qb * 256 + wid * 32 + r32, NT = 4 * (qb + 1), jfirst = sb ? NT - 1 : 0;
    const bf16_t* qp = proj + (rowbase + qrow) * PP + colQ + hi * 8;
#pragma unroll
    for (int d0 = 0; d0 < 4; ++d0) P.q[d0] = *(const bf16x8*)(qp + d0 * 16);
    const int srow = tid >> 3, sch = tid & 7;
    P.k0 = *(const u32x4*)(proj + (rowbase + srow + (size_t)jfirst * 64) * PP + colK + sch * 8);
    P.v0 = *(const u32x4*)(proj + (rowbase + srow + (size_t)jfirst * 64) * PP + colV + sch * 8);
    P.lf = (f32x4){0.f, 0.f, 0.f, 0.f};
    if (!sb && 4 * tid < 256 * (qb + 1)) P.lf = *(const f32x4*)((const float*)(p->ws + WS_LOGF) + ((size_t)b * 8 + h) * SEQ + 4 * tid);
}
template <bool SB>
DI void attn_unit(int b, int h, int qb, LAS unsigned char* lds, AttnPre& P, bool has_next, int nsb, int nb, int nh, int nqb) {
    const int dry = 0;
    const KP p = kparams();
    const int tid = opaque_tid(), lane = tid & 63, wid = __builtin_amdgcn_readfirstlane(tid >> 6), r32 = lane & 31, hi = lane >> 5;
    bf16_t* proj = (bf16_t*)(p->ws + WS_PROJ);
    const int colQ = (SB ? 2048 : 3584) + h * 64, colK = colQ + 512, colV = colQ + 1024;
    const size_t rowbase = (size_t)b * SEQ;
    const int qmin = qb * 256 + wid * 32, qmax = qmin + 31, qrow = qmin + r32;
    const int NT = 4 * (qb + 1);
    LAS float* bias = (LAS float*)(lds + AT_BIAS);
    bf16x8 qr[4];
#pragma unroll
    for (int d0 = 0; d0 < 4; ++d0) qr[d0] = P.q[d0];
    const int srow = tid >> 3, sch = tid & 7;
    const bf16_t* kg = proj + (rowbase + srow) * PP + colK + sch * 8;
    const bf16_t* vg = proj + (rowbase + srow) * PP + colV + sch * 8;
    const int soff = srow * 144 + sch * 16;
    const u32x4 kreg0 = P.k0, vreg0 = P.v0;
    if (!SB) {
        const float* lf = (const float*)(p->ws + WS_LOGF) + ((size_t)b * 8 + h) * SEQ;
        LAS float* scanw = (LAS float*)(lds + AT_SCAN);
        const int n = 256 * (qb + 1);
        const f32x4 v = P.lf;
        const float s1 = v[0], s2 = s1 + v[1], s3 = s2 + v[2], s4 = s3 + v[3];
        float sc = s4;
#pragma unroll
        for (int o = 1; o < 64; o <<= 1) { const float t = __shfl_up(sc, o); if (lane >= o) sc += t; }
        if (lane == 63) scanw[wid] = sc;
        __syncthreads();
        float off = sc - s4;
        for (int w = 0; w < wid; ++w) off += scanw[w];
        if (4 * tid < n) { f32x4 o; o[0] = -(off + s1) * LOG2E; o[1] = -(off + s2) * LOG2E; o[2] = -(off + s3) * LOG2E; o[3] = -(off + s4) * LOG2E; *(LAS f32x4*)(bias + 4 * tid) = o; }
    }
    *(LAS u32x4*)(lds + AT_K + soff) = kreg0; *(LAS u32x4*)(lds + AT_V + soff) = vreg0;
    __syncthreads();
    f32x16 y0, y1;
#pragma unroll
    for (int i = 0; i < 16; ++i) { y0[i] = 0.f; y1[i] = 0.f; }
    float mrun = -INFINITY, lrun = 0.f, carry = 0.f;
    LAS unsigned* xflag = (LAS unsigned*)(lds + AT_SCAN + 64);
    for (int it = 0; it < NT; ++it) {
        const int j = SB ? NT - 1 - it : it, buf = it & 1;
        const bool more = it + 1 < NT; const int jn = SB ? j - 1 : j + 1;
        u32x4 kreg, vreg;
        if (more) { kreg = *(const u32x4*)(kg + (size_t)jn * 64 * PP); vreg = *(const u32x4*)(vg + (size_t)jn * 64 * PP); }
        if (64 * j <= qmax && !(SB && __all(carry > 160.0f))) {
            const LAS unsigned char* Kb = lds + AT_K + buf * 9216; const LAS unsigned char* Vb = lds + AT_V + buf * 9216;
            f32x16 p0, p1;
            if (SB) {
#pragma unroll
                for (int i = 0; i < 16; ++i) { p0[i] = 0.f; p1[i] = 0.f; }
            } else {
                const LAS float* bp = bias + 64 * j + 4 * hi;
#pragma unroll
                for (int g = 0; g < 4; ++g) { const f32x4 t0 = *(const LAS f32x4*)(bp + 8 * g), t1 = *(const LAS f32x4*)(bp + 32 + 8 * g);
                    p0[4 * g] = t0[0]; p0[4 * g + 1] = t0[1]; p0[4 * g + 2] = t0[2]; p0[4 * g + 3] = t0[3];
                    p1[4 * g] = t1[0]; p1[4 * g + 1] = t1[1]; p1[4 * g + 2] = t1[2]; p1[4 * g + 3] = t1[3]; }
            }
#pragma unroll
            for (int d0 = 0; d0 < 4; ++d0) {
                const bf16x8 k0 = *(const LAS bf16x8*)(Kb + r32 * 144 + d0 * 32 + hi * 16), k1 = *(const LAS bf16x8*)(Kb + (32 + r32) * 144 + d0 * 32 + hi * 16);
                p0 = MFMA32(k0, qr[d0], p0); p1 = MFMA32(k1, qr[d0], p1);
            }
            const bool band = (64 * j + 63 >= qmin);
            if (SB) {
                float c0[16], c1[16];
#pragma unroll
                for (int i = 0; i < 16; ++i) {
                    const float z0 = p0[i], z1 = p1[i];
                    float a0 = fmaxf(z0, 0.f) + flog2(1.f + fexp2(-fabsf(z0))), a1 = fmaxf(z1, 0.f) + flog2(1.f + fexp2(-fabsf(z1)));
                    if (band) { const int kv = 64 * j + crow(i, hi); if (kv >= qrow) a0 = 0.f; if (kv + 32 >= qrow) a1 = 0.f; }
                    c0[i] = a0; c1[i] = a1;
                }
                float pr[8], tg[8];
#pragma unroll
                for (int g = 0; g < 4; ++g) { const float s0 = (c0[4 * g] + c0[4 * g + 1]) + (c0[4 * g + 2] + c0[4 * g + 3]), s1 = (c1[4 * g] + c1[4 * g + 1]) + (c1[4 * g + 2] + c1[4 * g + 3]);
                    tg[g] = __shfl_xor(s0, 32); tg[4 + g] = __shfl_xor(s1, 32); pr[g] = s0 + tg[g]; pr[4 + g] = s1 + tg[4 + g]; }
                float ps = 0.f;
#pragma unroll
                for (int g = 7; g >= 0; --g) {
                    const float sufex = carry + ps + (hi == 0 ? tg[g] : 0.f);
                    if (g >= 4) { const int gi = 4 * (g - 4);
                        const float C3 = sufex + c1[gi + 3], C2_ = C3 + c1[gi + 2], C1 = C2_ + c1[gi + 1], C0 = C1 + c1[gi];
                        p1[gi + 3] = fexp2(p1[gi + 3] - C3); p1[gi + 2] = fexp2(p1[gi + 2] - C2_); p1[gi + 1] = fexp2(p1[gi + 1] - C1); p1[gi] = fexp2(p1[gi] - C0);
                    } else { const int gi = 4 * g;
                        const float C3 = sufex + c0[gi + 3], C2_ = C3 + c0[gi + 2], C1 = C2_ + c0[gi + 1], C0 = C1 + c0[gi];
                        p0[gi + 3] = fexp2(p0[gi + 3] - C3); p0[gi + 2] = fexp2(p0[gi + 2] - C2_); p0[gi + 1] = fexp2(p0[gi + 1] - C1); p0[gi] = fexp2(p0[gi] - C0);
                    }
                    ps += pr[g];
                }
                carry += ps;
                if (band) {
#pragma unroll
                    for (int i = 0; i < 16; ++i) { const int kv = 64 * j + crow(i, hi); if (kv >= qrow) p0[i] = 0.f; if (kv + 32 >= qrow) p1[i] = 0.f; }
                }
            } else {
                if (band) {
#pragma unroll
                    for (int i = 0; i < 16; ++i) { const int kv = 64 * j + crow(i, hi); if (kv > qrow) p0[i] = -INFINITY; if (kv + 32 > qrow) p1[i] = -INFINITY; }
                }
                float rm = __builtin_fmaxf(p0[0], p1[0]), rm2 = __builtin_fmaxf(p0[1], p1[1]);
#pragma unroll
                for (int i = 2; i < 16; i += 2) { rm = __builtin_fmaxf(__builtin_fmaxf(rm, p0[i]), p1[i]); rm2 = __builtin_fmaxf(__builtin_fmaxf(rm2, p0[i + 1]), p1[i + 1]); }
                rm = __builtin_fmaxf(rm, rm2);
                rm = fmaxf(rm, __shfl_xor(rm, 32));
                if (__any(rm > mrun + 8.0f)) {
                    const float mnew = fmaxf(mrun, rm);
                    const float alpha = fexp2(mrun - mnew);
                    mrun = mnew; lrun *= alpha;
#pragma unroll
                    for (int i = 0; i < 16; ++i) { y0[i] *= alpha; y1[i] *= alpha; }
                }
                float rs = 0.f;
#pragma unroll
                for (int i = 0; i < 16; ++i) { p0[i] = fexp2(p0[i] - mrun); p1[i] = fexp2(p1[i] - mrun); rs += p0[i] + p1[i]; }
                lrun += rs;
            }
            const LAS unsigned char* vb = Vb + (4 * hi + ((lane & 15) >> 2)) * 144 + (16 * ((lane >> 4) & 1) + 4 * (lane & 3)) * 2;
#pragma unroll
            for (int pq = 0; pq < 2; ++pq)
#pragma unroll
                for (int ss = 0; ss < 2; ++ss) {
                    u32x4 pw;
                    if (pq == 0) { pw.x = cvtpk(p0[8 * ss], p0[8 * ss + 1]); pw.y = cvtpk(p0[8 * ss + 2], p0[8 * ss + 3]); pw.z = cvtpk(p0[8 * ss + 4], p0[8 * ss + 5]); pw.w = cvtpk(p0[8 * ss + 6], p0[8 * ss + 7]); }
                    else { pw.x = cvtpk(p1[8 * ss], p1[8 * ss + 1]); pw.y = cvtpk(p1[8 * ss + 2], p1[8 * ss + 3]); pw.z = cvtpk(p1[8 * ss + 4], p1[8 * ss + 5]); pw.w = cvtpk(p1[8 * ss + 6], p1[8 * ss + 7]); }
                    const bf16x8 xs = __builtin_bit_cast(bf16x8, pw);
                    const LAS unsigned char* vr = vb + (32 * pq + 16 * ss) * 144;
                    const s16x4 l0 = vtr(vr), h0 = vtr(vr + 8 * 144), l1 = vtr(vr + 64), h1 = vtr(vr + 8 * 144 + 64);
                    const bf16x8 pa0 = __builtin_shufflevector(l0, h0, 0, 1, 2, 3, 4, 5, 6, 7), pa1 = __builtin_shufflevector(l1, h1, 0, 1, 2, 3, 4, 5, 6, 7);
                    y0 = MFMA32(pa0, xs, y0); y1 = MFMA32(pa1, xs, y1);
                }
        }
        if (more) { *(LAS u32x4*)(lds + AT_K + (buf ^ 1) * 9216 + soff) = kreg; *(LAS u32x4*)(lds + AT_V + (buf ^ 1) * 9216 + soff) = vreg; }
        if (SB) {
            const bool sat = __all(carry > 160.0f);
            if (lane == 0) xflag[buf * 8 + wid] = sat ? 1u : 0u;
        }
        __syncthreads();
        if (SB) {
            unsigned allsat = 1u;
#pragma unroll
            for (int w = 0; w < 8; ++w) allsat &= xflag[buf * 8 + w];
            if (allsat) break;
        }
    }
    if (has_next) attn_prefetch(P, nsb, nb, nh, nqb);
    float inv = 1.f;
    if (!SB) { const float lt = lrun + __shfl_xor(lrun, 32); inv = 1.0f / lt; }
    bf16_t* op = proj + (rowbase + qrow) * PP + colQ + 4 * hi;
#pragma unroll
    for (int g = 0; g < 4; ++g) {
        u32x2 w0, w1;
        w0.x = cvtpk(y0[4 * g] * inv, y0[4 * g + 1] * inv); w0.y = cvtpk(y0[4 * g + 2] * inv, y0[4 * g + 3] * inv);
        w1.x = cvtpk(y1[4 * g] * inv, y1[4 * g + 1] * inv); w1.y = cvtpk(y1[4 * g + 2] * inv, y1[4 * g + 3] * inv);
        if (!dry) { *(u32x2*)(op + 8 * g) = w0; *(u32x2*)(op + 32 + 8 * g) = w1; }
    }
}


#define XB_TMO      128
#define XB_XCNT(j)  (256  + 64 * (j))
#define XB_XSUB(j)  (1280 + 64 * (j))
#define XB_XGEN(j)  (2304 + 64 * (j))
#define XB_TOP      3328
#define XB_TOPGEN   3392
#define XCD_BAR_WORDS 3456
#define XB_SPIN_CAP (1u << 18)
DI unsigned xb_ld(unsigned* p)              { return __hip_atomic_load(p, __ATOMIC_RELAXED, __HIP_MEMORY_SCOPE_AGENT); }
DI unsigned xb_add(unsigned* p, unsigned v) { return __hip_atomic_fetch_add(p, v, __ATOMIC_RELAXED, __HIP_MEMORY_SCOPE_AGENT); }
DI unsigned xb_xcc_id() { return (unsigned)__builtin_amdgcn_s_getreg((3 << 11) | 20) & 0xFu; }
#define XB_SPIN(cond, bar) do { unsigned _sp = 0; while (cond) { __builtin_amdgcn_s_sleep(1); \
    if ((++_sp & 255u) == 0u) { if (xb_ld(&(bar)[XB_TMO])) break; if (_sp > XB_SPIN_CAP) { atomicAdd(&(bar)[XB_TMO], 1u); break; } } } } while (0)
struct XcdBarrier { unsigned* bar; unsigned x; volatile LAS unsigned* st; };
DI XcdBarrier xcd_barrier_post(unsigned* bar, volatile LAS unsigned* st) {
    XcdBarrier b; b.bar = bar; b.x = xb_xcc_id(); b.st = st;
    if (threadIdx.x == 0) (void)xb_add(&bar[XB_XCNT(b.x)], 1u);
    return b;
}
DI void xcd_barrier_complete(unsigned* bar, unsigned x, unsigned& nloc, unsigned& nx) {
    const unsigned G = gridDim.x * gridDim.y * gridDim.z;
    unsigned sum, cnt, mine, sp = 0u;
    for (;;) {
        sum = 0u; cnt = 0u; mine = 0u;
#pragma unroll
        for (unsigned j = 0; j < 16; ++j) { const unsigned c = xb_ld(&bar[XB_XCNT(j)]); sum += c; cnt += (c > 0u) ? 1u : 0u; mine = (j == x) ? c : mine; }
        if (sum == G) break;
        __builtin_amdgcn_s_sleep(1);
        if ((++sp & 255u) == 0u) { if (xb_ld(&bar[XB_TMO])) break; if (sp > XB_SPIN_CAP) { atomicAdd(&bar[XB_TMO], 1u); break; } }
    }
    nloc = mine > 0u ? mine : 1u; nx = cnt > 0u ? cnt : 1u;
}
DI void xcd_barrier(const XcdBarrier& b) {
    asm volatile("s_waitcnt vmcnt(0)" ::: "memory");
    __syncthreads();
    if (threadIdx.x == 0) {
        unsigned* bar = b.bar;
        __builtin_amdgcn_s_waitcnt(0);
        unsigned nloc = b.st[0], nx = b.st[1];
        if (nloc == 0u) { xcd_barrier_complete(bar, b.x, nloc, nx); b.st[0] = nloc; b.st[1] = nx; }
        const unsigned old = xb_add(&bar[XB_XSUB(b.x)], 1u);
        const unsigned gen = old / nloc;
        if (old + 1u == (gen + 1u) * nloc) {
            __builtin_amdgcn_fence(__ATOMIC_RELEASE, "agent");
            asm volatile("s_waitcnt vmcnt(0)" ::: "memory");
            const unsigned og = xb_add(&bar[XB_TOP], 1u);
            const unsigned tg = og / nx;
            if (og + 1u == (tg + 1u) * nx) xb_add(&bar[XB_TOPGEN], 1u);
            else XB_SPIN(xb_ld(&bar[XB_TOPGEN]) == tg, bar);
            __builtin_amdgcn_fence(__ATOMIC_ACQUIRE, "agent");
            xb_add(&bar[XB_XGEN(b.x)], 1u);
            asm volatile("s_waitcnt vmcnt(0)" ::: "memory");
        } else {
            XB_SPIN(xb_ld(&bar[XB_XGEN(b.x)]) == gen, bar);
            __builtin_amdgcn_fence(__ATOMIC_ACQUIRE, "agent");
            asm volatile("s_waitcnt vmcnt(0)" ::: "memory");
        }
    }
    __syncthreads();
}

template <int KIND>
DI void run_gemm(LAS unsigned char* lds, int l, int ffn, int c, int sub, int dry = 0) {
    const KP p = kparams();
    unsigned char* ws = p->ws;
    pg8::EpiCtx E; E.hid = (bf16_t*)(ws + WS_HID); E.proj = (bf16_t*)(ws + WS_PROJ); E.hbuf = (KIND == 1 && l == 1 && ffn == 1) ? (bf16_t*)(ws + WS_DLAST) : (bf16_t*)p->out;
    E.mod = (const float*)(ws + WS_MOD) + (size_t)l * NB * NADA; E.merge_b = p->in[16] + (size_t)l * 3072;
    E.gscr = (bf16_t*)(ws + WS_GSCR) + (size_t)blockIdx.x * 65536; E.dry = dry;
    pg8::Sched S; S.kind = KIND; S.G = gridDim.x; S.c = c; S.sub = sub; S.A1 = nullptr; S.B1 = nullptr;
    if (KIND == 0) { S.A0 = (const char*)p->out; S.B0 = (const char*)(ws + (ffn ? WS_WUP2 : WS_WUP1)); }
    else if (KIND == 1) { S.A0 = (const char*)(ws + WS_HID); S.B0 = (const char*)(ws + (ffn ? WS_WDN2 : WS_WDN1)); }
    else if (KIND == 2) { S.A0 = (const char*)p->out; S.B0 = (const char*)(ws + WS_WIN); }
    else if (KIND == 3) { S.A0 = (const char*)p->out; S.B0 = (const char*)(ws + WS_WG); }
    else if (KIND == 5) { S.A0 = (const char*)(ws + WS_PROJ); S.B0 = (const char*)(ws + WS_WM); }
    else { S.A0 = (const char*)(ws + WS_PROJ); S.B0 = (const char*)(ws + WS_WO); }
    pg8::gemm_phase(lds, S, E);
}

__global__ void __launch_bounds__(NTHR, 2) fwd_megakernel(Params p_unused) {
    extern __shared__ __attribute__((aligned(16))) unsigned char lds_raw[];
    LAS unsigned char* lds = (LAS unsigned char*)lds_raw;
    cg::grid_group grid = cg::this_grid();
    const int G = gridDim.x, bx = blockIdx.x;
    { const KP p = kparams(); unsigned* bw = (unsigned*)p->ws;
      if (bx == 0) for (int i = threadIdx.x; i < XCD_BAR_WORDS; i += NTHR) __hip_atomic_store(bw + i, 0u, __ATOMIC_RELAXED, __HIP_MEMORY_SCOPE_AGENT);
      if (threadIdx.x < 2) ((volatile LAS unsigned*)(lds + 131072))[threadIdx.x] = 0u; }
#define GW_ARGS (int)(bx * NWAVES + __builtin_amdgcn_readfirstlane(opaque_tid() >> 6)), G * NWAVES

#ifndef NFWD
#define NFWD 1
#endif
    XcdBarrier xbar; xbar.bar = nullptr; xbar.x = 0; xbar.st = nullptr;
    for (int fwd = 0; fwd < NFWD; ++fwd) {
    if (REP(0)) for (int u = bx; u < 160; u += G) ada_unit(u, lds);
    if (RUN(0)) for (int u = bx; u < 160; u += G) ada_unit(u, lds);
    if (REP(1)) convert_weights(0, lds, GW_ARGS);
    if (RUN(1)) convert_weights(0, lds, GW_ARGS);
    if (fwd == 0) { grid.sync(); xbar = xcd_barrier_post((unsigned*)kparams()->ws, (volatile LAS unsigned*)(lds + 131072)); }
    else { XcdBarrier b_ = xbar; b_.bar = (unsigned*)kparams()->ws; xcd_barrier(b_); }
#define SEAM() do { XcdBarrier b_ = xbar; b_.bar = (unsigned*)kparams()->ws; xcd_barrier(b_); if (REP(16)) xcd_barrier(b_); } while (0)

    for (int l = 0; l < 2; ++l) {
        if (REP(1)) if (l == 1) convert_weights(1, lds, GW_ARGS);
        if (REP(2)) if (l == 0) norm_phase(l, 1, 0, lds, GW_ARGS);
        if (RUN(1)) if (l == 1) convert_weights(1, lds, GW_ARGS);
        if (RUN(2)) { if (l == 0) norm_phase(l, 1, 0, lds, GW_ARGS); else norm_phase(l, 0, 0, lds, GW_ARGS, 2, 0); }
        SEAM();
        if (REP(3)) run_gemm<0>(lds, l, 0, bx, 0, 1);
        if (RUN(3)) run_gemm<0>(lds, l, 0, bx, 0);
        SEAM();
        if (REP(4)) run_gemm<1>(lds, l, 0, bx, 0, 1);
        if (RUN(4)) run_gemm<1>(lds, l, 0, bx, 0);
        SEAM();
        if (RUN(5)) norm_phase(l, 2, 1, lds, GW_ARGS, 0, l);
        SEAM();
        if (REP(6)) run_gemm<2>(lds, l, 0, bx, 0, 1);
        if (RUN(6)) run_gemm<2>(lds, l, 0, bx, 0);
        SEAM();
        {
            AttnPre P; bool primed = false;
            for (int u = bx; u < 256 + 2048; u += G) {
                if (u < 256) { if (RUN(7)) rg_unit(l, u >> 4, u & 15, lds); continue; }
                const int a = u - 256, lv = a >> 8, cc = a & 255, qb = 7 - lv, bh = cc >> 1, sb = (((0x99 >> qb) ^ cc) & 1);
                if (!primed) { attn_prefetch(P, sb, bh >> 3, bh & 7, qb); primed = true; }
                const int un = u + G; const bool has_next = un < 256 + 2048;
                const int an = un - 256, lvn = an >> 8, ccn = an & 255, qbn = 7 - lvn, bhn = ccn >> 1, sbn = (((0x99 >> qbn) ^ ccn) & 1);
                if (sb) { if (RUN(8)) attn_unit<true>(bh >> 3, bh & 7, qb, lds, P, has_next, sbn, bhn >> 3, bhn & 7, qbn); else if (has_next) attn_prefetch(P, sbn, bhn >> 3, bhn & 7, qbn); }
                else { if (RUN(9)) attn_unit<false>(bh >> 3, bh & 7, qb, lds, P, has_next, sbn, bhn >> 3, bhn & 7, qbn); else if (has_next) attn_prefetch(P, sbn, bhn >> 3, bhn & 7, qbn); }
            }
        }
        SEAM();
        if (RUN(10)) {
            for (int L = bx; L < 512; L += G)
                for (int j = 0; j < 3; ++j) { if (REP(10)) { run_gemm<3>(lds, l, 0, L, j, 1); run_gemm<5>(lds, l, 0, L, j, 1); } run_gemm<3>(lds, l, 0, L, j); run_gemm<5>(lds, l, 0, L, j); }
        }
        SEAM();
        if (REP(11)) run_gemm<4>(lds, l, 0, bx, 1, 1);
        if (RUN(11)) run_gemm<4>(lds, l, 0, bx, 1);
        SEAM();
        if (RUN(12)) norm_phase(l, 0, 2, lds, GW_ARGS, 1, l);
        SEAM();
        if (REP(13)) run_gemm<0>(lds, l, 1, bx, 0, 1);
        if (RUN(13)) run_gemm<0>(lds, l, 1, bx, 0);
        SEAM();
        if (REP(14)) run_gemm<1>(lds, l, 1, bx, 2, 1);
        if (RUN(14)) run_gemm<1>(lds, l, 1, bx, 2);
        SEAM();
    }
    if (RUN(15)) norm_phase(0, 3, 0, lds, GW_ARGS, 2, 1);
    if (fwd + 1 < NFWD) SEAM();
    }
}

extern "C" void kernel_launch(void* const* d_in, const int* in_sizes, int n_in, void* d_out, int out_size, void* d_ws, size_t ws_size, hipStream_t stream) {
    static int grid = 0;
    if (grid == 0) {
        if (n_in != 30 || out_size != M * DM || ws_size < WS_END) { fprintf(stderr, "kernel_launch: unexpected shapes (n_in %d out %d ws %zu)\n", n_in, out_size, ws_size); grid = -1; return; }
        int dev = 0, cus = 0, per_cu = 0;
        (void)hipGetDevice(&dev);
        (void)hipDeviceGetAttribute(&cus, hipDeviceAttributeMultiprocessorCount, dev);
        if (hipFuncSetAttribute((const void*)fwd_megakernel, hipFuncAttributeMaxDynamicSharedMemorySize, LDS_BYTES) != hipSuccess) { fprintf(stderr, "kernel_launch: hipFuncSetAttribute failed\n"); grid = -1; return; }
        if (hipOccupancyMaxActiveBlocksPerMultiprocessor(&per_cu, (const void*)fwd_megakernel, NTHR, LDS_BYTES) != hipSuccess || per_cu < 1) per_cu = 1;
        (void)hipGetLastError();
        grid = cus >= 256 ? 256 : cus;
        (void)per_cu;
    }
    if (grid < 0) return;
    Params p{};
    for (int i = 0; i < 30; ++i) p.in[i] = (const float*)d_in[i];
    p.out = (float*)d_out; p.ws = (unsigned char*)d_ws;
    void* args[] = {&p};
    hipError_t e = hipLaunchCooperativeKernel((const void*)fwd_megakernel, dim3(grid), dim3(NTHR), args, LDS_BYTES, stream);
    if (e != hipSuccess) fprintf(stderr, "cooperative launch failed: %s (grid %d)\n", hipGetErrorString(e), grid);
}
```

```cpp
#include <hip/hip_runtime.h>
#include <hip/hip_cooperative_groups.h>
#include <cstdio>
#include <cstdint>
namespace cg = cooperative_groups;
#ifndef SKIPM
#define SKIPM 0
#endif
#define RUN(bit) (fwd != 0 || !((SKIPM) >> (bit) & 1))
#ifndef REPM
#define REPM 0
#endif
#define REP(bit) (((REPM) >> (bit)) & 1)

#define LAS __attribute__((address_space(3)))
#define DI __device__ __forceinline__
typedef unsigned short bf16_t;
typedef short bf16x8 __attribute__((ext_vector_type(8)));
typedef short s16x4 __attribute__((ext_vector_type(4)));
typedef float f32x4 __attribute__((ext_vector_type(4)));
typedef float f32x16 __attribute__((ext_vector_type(16)));
typedef unsigned u32x4 __attribute__((ext_vector_type(4)));
typedef unsigned u32x2 __attribute__((ext_vector_type(2)));

constexpr int NB = 16, SEQ = 2048, DM = 1024, DFF = 2816, M = NB * SEQ, PP = 5120  , NADA = 9216;
constexpr int NWAVES = 8, NTHR = 512;
constexpr float EPS = 1e-6f;
constexpr float LOG2E = 1.4426950408889634f;
constexpr float C2 = 0.125f * LOG2E;
constexpr size_t MiB = 1u << 20;
constexpr size_t WS_MOD = 1 * MiB;
constexpr size_t WS_FM = WS_MOD + (size_t)2 * NB * NADA * 4;
constexpr size_t WS_LOGF = 3 * MiB;
constexpr size_t WS_GSCR = 4 * MiB;
constexpr size_t WS_WUP1 = 36 * MiB;
constexpr size_t WS_WDN1 = 47 * MiB;
constexpr size_t WS_WUP2 = 53 * MiB;
constexpr size_t WS_WDN2 = 64 * MiB;
constexpr size_t WS_WIN = 70 * MiB;
constexpr size_t WS_WG = 80 * MiB;
constexpr size_t WS_WM = 86 * MiB;
constexpr size_t WS_WO = 90 * MiB;
constexpr size_t WS_XB = 92 * MiB;
constexpr size_t WS_DLAST = 332 * MiB;
constexpr size_t WS_PROJ = 156 * MiB;
constexpr size_t WS_HID = 156 * MiB;
constexpr size_t WS_END = 476 * MiB;
constexpr int LDS_BYTES = 147456;

struct Params { const float* in[30]; float* out; unsigned char* ws; };
typedef const __attribute__((address_space(4))) Params* KP;
__device__ __forceinline__ KP kparams() { KP q = (KP)__builtin_amdgcn_kernarg_segment_ptr(); asm volatile("" : "+s"(q)); return q; }

DI unsigned cvtpk(float lo, float hi) { typedef float f2 __attribute__((ext_vector_type(2))); typedef __bf16 b2 __attribute__((ext_vector_type(2))); f2 v = {lo, hi}; b2 b = __builtin_convertvector(v, b2); return __builtin_bit_cast(unsigned, b); }
DI float bf_lo(unsigned w) { return __uint_as_float(w << 16); }
DI float bf_hi(unsigned w) { return __uint_as_float(w & 0xffff0000u); }
DI float bf1(bf16_t v) { return __uint_as_float(((unsigned)v) << 16); }
DI bf16_t f2bf(float f) { return (bf16_t)(cvtpk(f, 0.f) & 0xffffu); }
DI float fexp2(float x) { return __builtin_amdgcn_exp2f(x); }
DI float flog2(float x) { return __builtin_amdgcn_logf(x); }
DI float frcp(float x) { return __builtin_amdgcn_rcpf(x); }
DI float sigmoidf(float v) { return frcp(1.f + fexp2(-v * LOG2E)); }
DI int opaque_tid() { int t = threadIdx.x; asm volatile("" : "+v"(t)); return t; }
DI float wave_sum(float v) {
#pragma unroll
    for (int o = 1; o < 64; o <<= 1) v += __shfl_xor(v, o);
    return v;
}
#define MFMA32(a, b, c) __builtin_amdgcn_mfma_f32_32x32x16_bf16((a), (b), (c), 0, 0, 0)
#define MFMA16(a, b, c) __builtin_amdgcn_mfma_f32_16x16x32_bf16((a), (b), (c), 0, 0, 0)

namespace pg8 {
constexpr int BM = 256, BK = 64, HALF = 128, HTB = HALF * BK * 2, STAGE_BYTES = 8 * HTB, NXCD = 8, WGM = 8;
DI int lds_byte(int r, int c) { const int st = (r >> 4) * 2 + (c >> 5), rr = r & 15, cc = c & 31, ob = rr * 64 + cc * 2; return st * 1024 + (ob ^ (((ob >> 9) & 1) << 5)); }
DI void stage_rc(int b, int& R, int& C) { const int st = b / 1024, sb = b % 1024, swz = sb ^ (((sb >> 9) & 1) << 5); R = (st >> 1) * 16 + swz / 64; C = (st & 1) * 32 + (swz % 64) / 2; }
DI int perm32(int rho) { const int n = rho >> 4, i = rho & 15; return 8 * (i >> 2) + 4 * n + (i & 3); }

enum { MODE_SWIGLU = 0, MODE_RESID = 1, MODE_PROJ = 2, MODE_GATE = 3, MODE_BRANCH = 4 };
struct Unit { const char* A; const char* B; unsigned lda, ldb; int nt, mode, pm, pn, aux; };
struct EpiCtx { bf16_t* hid; bf16_t* proj; bf16_t* hbuf; const float* mod; const float* merge_b; bf16_t* gscr; int dry; };

DI void tile_of(int L, int nM, int nN, int& pm, int& pn) {
    const int nwg = nM * nN; int wgid = L;
    { const int q = nwg / NXCD, r = nwg % NXCD, xcd = wgid % NXCD, off = wgid / NXCD; wgid = (xcd < r ? xcd * (q + 1) : r * (q + 1) + (xcd - r) * q) + off; }
    const int nig = WGM * nN, gid = wgid / nig, fm = gid * WGM, gsz = (nM - fm) < WGM ? (nM - fm) : WGM;
    pm = fm + ((wgid % nig) % gsz); pn = (wgid % nig) / gsz;
}

struct Sched {
    int kind, G, c, sub;
    const char *A0, *B0, *A1, *B1;
    DI bool next(int i, Unit& u) const {
        if (kind == 0) { const long L = (long)i * G + c; if (L >= 128 * 22) return false; tile_of((int)L, 128, 22, u.pm, u.pn);
            u.lda = 2048u; u.ldb = 2048u; u.A = A0 + (size_t)u.pm * 256 * 2048; u.B = B0 + (size_t)u.pn * 256 * 2048; u.nt = 16; u.mode = MODE_SWIGLU; u.aux = 0; return true; }
        if (kind == 1) { const long L = (long)i * G + c; if (L >= 128 * 4) return false; tile_of((int)L, 128, 4, u.pm, u.pn);
            u.lda = 5632u; u.ldb = 5632u; u.A = A0 + (size_t)u.pm * 256 * 5632; u.B = B0 + (size_t)u.pn * 256 * 5632; u.nt = 44; u.mode = MODE_RESID; u.aux = sub; return true; }
        if (kind == 2) { const long L = (long)i * G + c; if (L >= 128 * 20) return false; tile_of((int)L, 128, 20, u.pm, u.pn);
            u.lda = 2048u; u.ldb = 2048u; u.A = A0 + (size_t)u.pm * 256 * 2048; u.B = B0 + (size_t)u.pn * 256 * 2048; u.nt = 16; u.mode = MODE_PROJ; u.aux = 0; return true; }
        if (kind == 3) { if (i != 0) return false; tile_of(c, 128, 4, u.pm, u.pn); const int j = sub; u.aux = j;
            u.lda = 2048u; u.ldb = 2048u; u.A = A0 + (size_t)u.pm * 256 * 2048; u.B = B0 + (size_t)(j * 1024 + u.pn * 256) * 2048; u.nt = 16; u.mode = MODE_GATE; return true; }
        if (kind == 5) { if (i != 0) return false; tile_of(c, 128, 4, u.pm, u.pn); const int j = sub; u.aux = j;
            const int acol = (j == 0) ? 1024 : (j == 1 ? 2048 : 3584), kcol = (j == 0) ? 0 : (j == 1 ? 1024 : 1536);
            u.lda = PP * 2u; u.ldb = 4096u; u.A = A0 + (size_t)u.pm * 256 * (PP * 2) + acol * 2; u.B = B0 + (size_t)u.pn * 256 * 4096 + kcol * 2; u.nt = (j == 0) ? 16 : 8; u.mode = MODE_BRANCH; return true; }
        { const long L = (long)i * G + c; if (L >= 128 * 4) return false; tile_of((int)L, 128, 4, u.pm, u.pn);
            u.lda = PP * 2u; u.ldb = 2048u; u.A = A0 + (size_t)u.pm * 256 * (PP * 2); u.B = B0 + (size_t)u.pn * 256 * 2048; u.nt = 16; u.mode = MODE_RESID; u.aux = 1; return true; }
    }
};

DI void epilogue(const f32x4 (&acc)[2][2][4][2], const Unit& u, const EpiCtx& E, int tid, int wr, int wc, int fr, int fq) {
    const int row0 = u.pm * BM + wr * 64 + fr, colw = wc * 32 + 8 * fq;
    if (u.mode == MODE_SWIGLU) {
#pragma unroll
        for (int ai = 0; ai < 2; ++ai)
#pragma unroll
            for (int m = 0; m < 4; ++m) {
                bf16_t* rowp = E.hid + (size_t)(row0 + ai * HALF + m * 16) * DFF + u.pn * 128 + colw;
                float o[8];
#pragma unroll
                for (int n = 0; n < 2; ++n)
#pragma unroll
                    for (int e = 0; e < 4; ++e) { const float a = acc[ai][0][m][n][e], g = acc[ai][1][m][n][e]; o[4 * n + e] = a * sigmoidf(a) * g; }
                u32x4 w; w.x = cvtpk(o[0], o[1]); w.y = cvtpk(o[2], o[3]); w.z = cvtpk(o[4], o[5]); w.w = cvtpk(o[6], o[7]);
                *(u32x4*)rowp = w;
            }
    } else if (u.mode == MODE_RESID) {
#pragma unroll
        for (int ai = 0; ai < 2; ++ai)
#pragma unroll
            for (int m = 0; m < 4; ++m) {
                bf16_t* rowp = E.hbuf + (size_t)(row0 + ai * HALF + m * 16) * DM + u.pn * BM + colw;
#pragma unroll
                for (int bj = 0; bj < 2; ++bj) { const f32x4 v0 = acc[ai][bj][m][0], v1 = acc[ai][bj][m][1];
                    u32x4 w; w.x = cvtpk(v0[0], v0[1]); w.y = cvtpk(v0[2], v0[3]); w.z = cvtpk(v1[0], v1[1]); w.w = cvtpk(v1[2], v1[3]);
                    *(u32x4*)(rowp + bj * HALF) = w; }
            }
    } else if (u.mode == MODE_PROJ) {
        const float sc = (u.pn == 8 || u.pn == 9 || u.pn == 14 || u.pn == 15) ? C2 : 1.0f;
#pragma unroll
        for (int ai = 0; ai < 2; ++ai)
#pragma unroll
            for (int m = 0; m < 4; ++m) {
                bf16_t* rowp = E.proj + (size_t)(row0 + ai * HALF + m * 16) * PP + u.pn * BM + colw;
#pragma unroll
                for (int bj = 0; bj < 2; ++bj) { const f32x4 v0 = acc[ai][bj][m][0] * sc, v1 = acc[ai][bj][m][1] * sc;
                    u32x4 w; w.x = cvtpk(v0[0], v0[1]); w.y = cvtpk(v0[2], v0[3]); w.z = cvtpk(v1[0], v1[1]); w.w = cvtpk(v1[2], v1[3]);
                    *(u32x4*)(rowp + bj * HALF) = w; }
            }
    } else if (u.mode == MODE_GATE) {
        const float* bp = E.merge_b + u.aux * 1024 + u.pn * BM + colw;
        f32x4 bv[2][2];
#pragma unroll
        for (int bj = 0; bj < 2; ++bj)
#pragma unroll
            for (int n = 0; n < 2; ++n) bv[bj][n] = *(const f32x4*)(bp + bj * HALF + 4 * n);
#pragma unroll
        for (int ai = 0; ai < 2; ++ai)
#pragma unroll
            for (int m = 0; m < 4; ++m)
#pragma unroll
                for (int bj = 0; bj < 2; ++bj) { float o[8];
#pragma unroll
                    for (int n = 0; n < 2; ++n)
#pragma unroll
                        for (int e = 0; e < 4; ++e) o[4 * n + e] = sigmoidf(acc[ai][bj][m][n][e] + bv[bj][n][e]);
                    u32x4 w; w.x = cvtpk(o[0], o[1]); w.y = cvtpk(o[2], o[3]); w.z = cvtpk(o[4], o[5]); w.w = cvtpk(o[6], o[7]);
                    *(u32x4*)(E.gscr + ((size_t)(((ai * 4 + m) * 2 + bj) * NTHR) + tid) * 8) = w; }
    } else {
        const float dm = (E.dry && u.aux != 0) ? 0.0f : 1.0f;
#pragma unroll
        for (int ai = 0; ai < 2; ++ai)
#pragma unroll
            for (int m = 0; m < 4; ++m) {
                bf16_t* rowp = E.proj + (size_t)(row0 + ai * HALF + m * 16) * PP + u.pn * BM + colw;
#pragma unroll
                for (int bj = 0; bj < 2; ++bj) {
                    const u32x4 g = *(const u32x4*)(E.gscr + ((size_t)(((ai * 4 + m) * 2 + bj) * NTHR) + tid) * 8);
                    float o[8];
                    o[0] = dm * bf_lo(g.x) * acc[ai][bj][m][0][0]; o[1] = dm * bf_hi(g.x) * acc[ai][bj][m][0][1]; o[2] = dm * bf_lo(g.y) * acc[ai][bj][m][0][2]; o[3] = dm * bf_hi(g.y) * acc[ai][bj][m][0][3];
                    o[4] = dm * bf_lo(g.z) * acc[ai][bj][m][1][0]; o[5] = dm * bf_hi(g.z) * acc[ai][bj][m][1][1]; o[6] = dm * bf_lo(g.w) * acc[ai][bj][m][1][2]; o[7] = dm * bf_hi(g.w) * acc[ai][bj][m][1][3];
                    if (u.aux != 0) { const u32x4 q = *(const u32x4*)(rowp + bj * HALF);
                        o[0] += bf_lo(q.x); o[1] += bf_hi(q.x); o[2] += bf_lo(q.y); o[3] += bf_hi(q.y); o[4] += bf_lo(q.z); o[5] += bf_hi(q.z); o[6] += bf_lo(q.w); o[7] += bf_hi(q.w); }
                    u32x4 w; w.x = cvtpk(o[0], o[1]); w.y = cvtpk(o[2], o[3]); w.z = cvtpk(o[4], o[5]); w.w = cvtpk(o[6], o[7]);
                    *(u32x4*)(rowp + bj * HALF) = w; }
                if (m & 1) asm volatile("" ::: "memory");
            }
    }
}

DI void gemm_phase(LAS unsigned char* lds, const Sched& S, const EpiCtx& E) {
    const int tid = opaque_tid(), wid = __builtin_amdgcn_readfirstlane(tid >> 6), lane = tid & 63, wr = wid >> 2, wc = wid & 3, fr = lane & 15, fq = lane >> 4;
    int R0, C0; stage_rc(tid * 16, R0, C0);
    const int Rb0 = (R0 & ~31) + perm32(R0 & 31);
    const size_t kstep = (size_t)(BK * 2);
    const unsigned ldsw = (unsigned)wid * 1024u;
    const int aoff = lds_byte(wr * 64 + fr, fq * 8), boff = lds_byte(wc * 32 + fr, fq * 8);
#define PG8_SA(b, h) (((b) * 2 + (h)) * HTB)
#define PG8_SB(b, h) ((4 + (b) * 2 + (h)) * HTB)
#define PG8_STAGE(bufoff, gbase, v0, ld) do { \
        __builtin_amdgcn_global_load_lds((const unsigned*)((const char*)(gbase) + (v0)), (LAS unsigned*)(lds + (bufoff) + ldsw), 16, 0, 0); \
        __builtin_amdgcn_global_load_lds((const unsigned*)((const char*)(gbase) + (size_t)(ld) * 64 + (v0)), (LAS unsigned*)(lds + (bufoff) + ldsw + 8192), 16, 0, 0); } while (0)
#define PG8_LDA(dst, b, h) do { _Pragma("unroll") for (int m = 0; m < 4; ++m) _Pragma("unroll") for (int k = 0; k < 2; ++k) dst[m][k] = *(const LAS bf16x8*)(lds + PG8_SA(b, h) + aoff + m * 2048 + k * 1024); } while (0)
#define PG8_LDB(dst, b, h) do { _Pragma("unroll") for (int n = 0; n < 2; ++n) _Pragma("unroll") for (int k = 0; k < 2; ++k) dst[n][k] = *(const LAS bf16x8*)(lds + PG8_SB(b, h) + boff + n * 2048 + k * 1024); } while (0)
#define PG8_MMA(ai, bj, At, Bt) do { __builtin_amdgcn_s_setprio(1); _Pragma("unroll") for (int m = 0; m < 4; ++m) _Pragma("unroll") for (int n = 0; n < 2; ++n) _Pragma("unroll") for (int k = 0; k < 2; ++k) \
        acc[ai][bj][m][n] = __builtin_amdgcn_mfma_f32_16x16x32_bf16(Bt[n][k], At[m][k], acc[ai][bj][m][n], 0, 0, 0); __builtin_amdgcn_s_setprio(0); } while (0)
#define PG8_WAIT_V(n) asm volatile("s_waitcnt vmcnt(" #n ")" ::: "memory")
#define PG8_WAIT_L(n) asm volatile("s_waitcnt lgkmcnt(" #n ")" ::: "memory")
#define PG8_BAR __builtin_amdgcn_s_barrier()
#define PG8_SCHED __builtin_amdgcn_sched_barrier(0)
    Unit cur, nxt; int ui = 0;
    if (!S.next(0, cur)) return;
    f32x4 acc[2][2][4][2];
#pragma unroll
    for (int a = 0; a < 2; ++a)
#pragma unroll
        for (int b = 0; b < 2; ++b)
#pragma unroll
            for (int m = 0; m < 4; ++m)
#pragma unroll
                for (int n = 0; n < 2; ++n) acc[a][b][m][n] = (f32x4){0.f, 0.f, 0.f, 0.f};
    bf16x8 At[4][2], B0[2][2], B1[2][2];
    const char* cA = cur.A; const char* cB = cur.B;
    unsigned vA0 = (unsigned)R0 * cur.lda + (unsigned)C0 * 2u, vB0 = (unsigned)Rb0 * cur.ldb + (unsigned)C0 * 2u;
    unsigned lA = cur.lda, lB = cur.ldb;
    size_t hA = (size_t)HALF * cur.lda, hB = (size_t)HALF * cur.ldb;
    PG8_STAGE(PG8_SB(0, 0), cB, vB0, lB); PG8_STAGE(PG8_SB(0, 1), cB + hB, vB0, lB); PG8_STAGE(PG8_SA(0, 0), cA, vA0, lA); PG8_STAGE(PG8_SA(0, 1), cA + hA, vA0, lA);
    if (wr == 1) PG8_BAR;
    PG8_WAIT_V(2); PG8_BAR;
    PG8_STAGE(PG8_SB(1, 0), cB + kstep, vB0, lB); PG8_STAGE(PG8_SA(1, 0), cA + kstep, vA0, lA); PG8_STAGE(PG8_SB(1, 1), cB + hB + kstep, vB0, lB);
    PG8_WAIT_V(6); PG8_BAR;
    for (;;) {
        const bool has_next = S.next(ui + 1, nxt);
        const char* nA = has_next ? nxt.A : cA; const char* nB = has_next ? nxt.B : cB;
        const unsigned nlda = has_next ? nxt.lda : cur.lda, nldb = has_next ? nxt.ldb : cur.ldb;
        const unsigned nvA0 = (unsigned)R0 * nlda + (unsigned)C0 * 2u, nvB0 = (unsigned)Rb0 * nldb + (unsigned)C0 * 2u;
        const size_t nhA = (size_t)HALF * nlda, nhB = (size_t)HALF * nldb;
        const int nt = cur.nt;
        for (int t = 0; t < nt; t += 2) {
            const bool last = (t == nt - 2);
            const char* a1 = cA + (size_t)(t + 1) * kstep;
            const char* a2 = last ? nA : cA + (size_t)(t + 2) * kstep; const char* b2 = last ? nB : cB + (size_t)(t + 2) * kstep;
            const char* a3 = a2 + kstep; const char* b3 = b2 + kstep;
            const unsigned xA0 = last ? nvA0 : vA0, xB0 = last ? nvB0 : vB0, xlA = last ? nlda : lA, xlB = last ? nldb : lB;
            const size_t xhA = last ? nhA : hA, xhB = last ? nhB : hB;
            PG8_LDB(B0, 0, 0); PG8_LDB(B1, 0, 1); PG8_SCHED; PG8_LDA(At, 0, 0); PG8_STAGE(PG8_SA(1, 1), a1 + hA, vA0, lA);
            PG8_WAIT_V(8); PG8_WAIT_L(0); PG8_BAR; PG8_MMA(0, 0, At, B0); PG8_MMA(0, 1, At, B1); PG8_BAR; PG8_SCHED;
            PG8_LDA(At, 0, 1); PG8_STAGE(PG8_SB(0, 0), b2, xB0, xlB); PG8_STAGE(PG8_SB(0, 1), b2 + xhB, xB0, xlB); PG8_STAGE(PG8_SA(0, 0), a2, xA0, xlA);
            PG8_WAIT_V(8); PG8_WAIT_L(0); PG8_BAR; PG8_MMA(1, 0, At, B0); PG8_MMA(1, 1, At, B1); PG8_BAR; PG8_SCHED;
            PG8_LDB(B0, 1, 0); PG8_LDB(B1, 1, 1); PG8_SCHED; PG8_LDA(At, 1, 0); PG8_STAGE(PG8_SA(0, 1), a2 + xhA, xA0, xlA);
            PG8_WAIT_V(8); PG8_WAIT_L(0); PG8_BAR; PG8_MMA(0, 0, At, B0); PG8_MMA(0, 1, At, B1); PG8_BAR; PG8_SCHED;
            PG8_LDA(At, 1, 1); PG8_STAGE(PG8_SB(1, 0), b3, xB0, xlB); PG8_STAGE(PG8_SB(1, 1), b3 + xhB, xB0, xlB); PG8_STAGE(PG8_SA(1, 0), a3, xA0, xlA);
            PG8_WAIT_V(8); PG8_WAIT_L(0); PG8_BAR; PG8_MMA(1, 0, At, B0); PG8_MMA(1, 1, At, B1); PG8_BAR; PG8_SCHED;
        }
        if (wr == 0) PG8_BAR;
        epilogue(acc, cur, E, tid, wr, wc, fr, fq);
        if (!has_next) break;
#pragma unroll
        for (int a = 0; a < 2; ++a)
#pragma unroll
            for (int b = 0; b < 2; ++b)
#pragma unroll
                for (int m = 0; m < 4; ++m)
#pragma unroll
                    for (int n = 0; n < 2; ++n) acc[a][b][m][n] = (f32x4){0.f, 0.f, 0.f, 0.f};
        cur = nxt; cA = nA; cB = nB; vA0 = nvA0; vB0 = nvB0; lA = nlda; lB = nldb; hA = nhA; hB = nhB; ++ui;
        if (wr == 1) PG8_BAR;
    }
    PG8_WAIT_V(0);
    PG8_BAR;
#undef PG8_SA
#undef PG8_SB
#undef PG8_STAGE
#undef PG8_LDA
#undef PG8_LDB
#undef PG8_MMA
#undef PG8_WAIT_V
#undef PG8_WAIT_L
#undef PG8_BAR
#undef PG8_SCHED
}
}

DI void tr_item(const float* src, int srcP, int srcCol, int k0, bf16_t* dst, int dstP, int dstRow, int dstK, LAS float* scr, int lane) {
    float tv[32];
#pragma unroll
    for (int i = 0; i < 32; ++i) { const int kk = 2 * i + (lane >> 5); tv[i] = __builtin_nontemporal_load(src + (size_t)(k0 + kk) * srcP + srcCol + (lane & 31)); }
#pragma unroll
    for (int i = 0; i < 32; ++i) { const int kk = 2 * i + (lane >> 5); scr[kk * 33 + (lane & 31)] = tv[i]; }
    asm volatile("s_waitcnt lgkmcnt(0)" ::: "memory");
    const int c = lane & 7;
#pragma unroll
    for (int j = 0; j < 4; ++j) { const int n = (lane >> 3) + 8 * j; const LAS float* s = scr + (8 * c) * 33 + n;
        u32x4 o; o.x = cvtpk(s[0 * 33], s[1 * 33]); o.y = cvtpk(s[2 * 33], s[3 * 33]); o.z = cvtpk(s[4 * 33], s[5 * 33]); o.w = cvtpk(s[6 * 33], s[7 * 33]);
        *(u32x4*)(dst + (size_t)(dstRow + n) * dstP + dstK + k0 + 8 * c) = o; }
    asm volatile("s_waitcnt lgkmcnt(0)" ::: "memory");
}
DI void tr_job(int r, const float* src, int srcP, int srcC, int N, bf16_t* dst, int dstP, int dstK, int upHalf, LAS float* scr, int lane) {
    const int nblk = N / 32, kb = r / nblk, nb = r - kb * nblk, n0 = nb * 32;
    const int dstRow = (upHalf >= 0) ? ((n0 >> 7) * 256 + upHalf * 128 + (n0 & 127)) : n0;
    tr_item(src, srcP, srcC + n0, kb * 64, dst, dstP, dstRow, dstK, scr, lane);
}
DI void convert_weights(int l, LAS unsigned char* lds, int gw, int ngw) {
    const KP p = kparams();
    const int lane = opaque_tid() & 63, wave = gw & 7;
    LAS float* scr = (LAS float*)(lds + wave * 16384);
    unsigned char* ws = p->ws;
    const float* w1a = p->in[3] + (size_t)l * DM * DFF; const float* w3a = p->in[4] + (size_t)l * DM * DFF; const float* w2a = p->in[5] + (size_t)l * DFF * DM;
    const float* w1b = p->in[22] + (size_t)l * DM * DFF; const float* w3b = p->in[23] + (size_t)l * DM * DFF; const float* w2b = p->in[24] + (size_t)l * DFF * DM;
    const float* win = p->in[7] + (size_t)l * DM * 8200;
    const float* wrg = p->in[17] + (size_t)l * 1024 * 1024; const float* wsb = p->in[18] + (size_t)l * 512 * 1024; const float* wfx = p->in[19] + (size_t)l * 512 * 1024;
    const float* wo = p->in[20] + (size_t)l * 1024 * 1024;
    constexpr int I_UP = 16 * 88, I_DN = 44 * 32, I_IN = 16 * 160, I_G = 16 * 96, I_RG = 16 * 32, I_SB = 8 * 32, I_O = 16 * 32;
    constexpr int NITEMS = 4 * I_UP + 2 * I_DN + I_IN + I_G + I_RG + 2 * I_SB + I_O;
    const int ipw = (NITEMS + ngw - 1) / ngw;
    for (int it = gw * ipw; it < (gw + 1) * ipw && it < NITEMS; ++it) {
        int r = it;
        if (r < I_UP) { tr_job(r, w1a, DFF, 0, DFF, (bf16_t*)(ws + WS_WUP1), 1024, 0, 0, scr, lane); continue; } r -= I_UP;
        if (r < I_UP) { tr_job(r, w3a, DFF, 0, DFF, (bf16_t*)(ws + WS_WUP1), 1024, 0, 1, scr, lane); continue; } r -= I_UP;
        if (r < I_DN) { tr_job(r, w2a, DM, 0, DM, (bf16_t*)(ws + WS_WDN1), DFF, 0, -1, scr, lane); continue; } r -= I_DN;
        if (r < I_UP) { tr_job(r, w1b, DFF, 0, DFF, (bf16_t*)(ws + WS_WUP2), 1024, 0, 0, scr, lane); continue; } r -= I_UP;
        if (r < I_UP) { tr_job(r, w3b, DFF, 0, DFF, (bf16_t*)(ws + WS_WUP2), 1024, 0, 1, scr, lane); continue; } r -= I_UP;
        if (r < I_DN) { tr_job(r, w2b, DM, 0, DM, (bf16_t*)(ws + WS_WDN2), DFF, 0, -1, scr, lane); continue; } r -= I_DN;
        if (r < I_IN) { tr_job(r, win, 8200, 0, 5120, (bf16_t*)(ws + WS_WIN), 1024, 0, -1, scr, lane); continue; } r -= I_IN;
        if (r < I_G) { tr_job(r, win, 8200, 5128, 3072, (bf16_t*)(ws + WS_WG), 1024, 0, -1, scr, lane); continue; } r -= I_G;
        if (r < I_RG) { tr_job(r, wrg, 1024, 0, 1024, (bf16_t*)(ws + WS_WM), 2048, 0, -1, scr, lane); continue; } r -= I_RG;
        if (r < I_SB) { tr_job(r, wsb, 1024, 0, 1024, (bf16_t*)(ws + WS_WM), 2048, 1024, -1, scr, lane); continue; } r -= I_SB;
        if (r < I_SB) { tr_job(r, wfx, 1024, 0, 1024, (bf16_t*)(ws + WS_WM), 2048, 1536, -1, scr, lane); continue; } r -= I_SB;
        tr_job(r, wo, 1024, 0, 1024, (bf16_t*)(ws + WS_WO), 1024, 0, -1, scr, lane);
    }
}

DI void ada_unit(int u, LAS unsigned char* lds) {
    const KP p = kparams();
    const int tid = opaque_tid();
    LAS float* cT = (LAS float*)lds;
    LAS float* red = (LAS float*)(lds + 65536);
    const float* c = p->in[1];
    for (int i = tid; i < NB * DM; i += NTHR) { const int b = i >> 10, k = i & 1023; const float v = c[i]; cT[k * 16 + b] = v * sigmoidf(v); }
    __syncthreads();
    const float* W; const float* bias; float* out; int pitch, j0;
    if (u < 144) { const int l = u / 72, uu = u - l * 72; j0 = uu * 128; pitch = NADA; W = p->in[25] + (size_t)l * DM * NADA; bias = p->in[26] + (size_t)l * NADA; out = (float*)(p->ws + WS_MOD) + (size_t)l * NB * NADA; }
    else { j0 = (u - 144) * 128; pitch = 2048; W = p->in[28]; bias = p->in[29]; out = (float*)(p->ws + WS_FM); }
    const int col = tid & 127, q = tid >> 7;
    float acc[16];
#pragma unroll
    for (int b = 0; b < 16; ++b) acc[b] = 0.f;
    const float* wp = W + (size_t)(q * 256) * pitch + j0 + col;
    for (int k0 = 0; k0 < 256; k0 += 16) {
        float wv[16];
#pragma unroll
        for (int kk = 0; kk < 16; ++kk) wv[kk] = __builtin_nontemporal_load(wp + (size_t)(k0 + kk) * pitch);
#pragma unroll
        for (int kk = 0; kk < 16; ++kk) {
            const float w = wv[kk];
            const LAS f32x4* cp = (const LAS f32x4*)(cT + (q * 256 + k0 + kk) * 16);
            const f32x4 c0 = cp[0], c1 = cp[1], c2 = cp[2], c3 = cp[3];
            acc[0] += c0[0] * w; acc[1] += c0[1] * w; acc[2] += c0[2] * w; acc[3] += c0[3] * w;
            acc[4] += c1[0] * w; acc[5] += c1[1] * w; acc[6] += c1[2] * w; acc[7] += c1[3] * w;
            acc[8] += c2[0] * w; acc[9] += c2[1] * w; acc[10] += c2[2] * w; acc[11] += c2[3] * w;
            acc[12] += c3[0] * w; acc[13] += c3[1] * w; acc[14] += c3[2] * w; acc[15] += c3[3] * w;
        }
    }
#pragma unroll
    for (int b = 0; b < 16; ++b) red[(q * 16 + b) * 128 + col] = acc[b];
    __syncthreads();
    for (int i = tid; i < 16 * 128; i += NTHR) { const int b = i >> 7, cc = i & 127;
        const float s = red[(0 * 16 + b) * 128 + cc] + red[(1 * 16 + b) * 128 + cc] + red[(2 * 16 + b) * 128 + cc] + red[(3 * 16 + b) * 128 + cc];
        out[(size_t)b * pitch + j0 + cc] = s + bias[j0 + cc]; }
    __syncthreads();
}

DI void norm_phase(int l, int mode, int sub, LAS unsigned char* lds, int gw, int ngw, int dsub = -1, int dl = 0) {
    const KP p = kparams();
    const int lane = opaque_tid() & 63;
    const float* xin = p->in[0];
    bf16_t* xb = (bf16_t*)(p->ws + WS_XB);
    const bf16_t* dsrc = (mode == 3) ? (const bf16_t*)(p->ws + WS_DLAST) : (const bf16_t*)p->out;
    const float* gain = (mode == 3) ? p->in[27] : ((sub == 0 ? p->in[2] : (sub == 1 ? p->in[6] : p->in[21])) + (size_t)l * DM);
    const float* mod = (mode == 3) ? (const float*)(p->ws + WS_FM) : ((const float*)(p->ws + WS_MOD) + (size_t)l * NB * NADA + sub * 3072);
    const int mpitch = (mode == 3) ? 2048 : NADA;
    bf16_t* hout = (bf16_t*)p->out;
    LAS float* wfT = (LAS float*)lds;
    if (mode == 2) {
        const float* win = p->in[7] + (size_t)l * DM * 8200 + 5120;
        for (int i = opaque_tid(); i < 8192; i += NTHR) { const int k = i >> 3, j = i & 7; wfT[j * 1024 + k] = win[(size_t)k * 8200 + j]; }
        __syncthreads();
    }
    f32x4 g[4];
#pragma unroll
    for (int j = 0; j < 4; ++j) g[j] = *(const f32x4*)(gain + 4 * lane + 256 * j);
    constexpr int RPW = 4;
    const int rows_per_wave = M / ngw;
    const int mw0 = gw * rows_per_wave, b = mw0 >> 11;
    f32x4 sh[4], sc[4], gt[4];
    {
        const float* mp = mod + (size_t)b * mpitch + 4 * lane;
        const float coef = (dsub == 1) ? 1.0f : 0.5f;
        const float* gp = (const float*)(p->ws + WS_MOD) + (size_t)dl * NB * NADA + (size_t)b * NADA + (dsub >= 0 ? dsub : 0) * 3072 + 2048 + 4 * lane;
        f32x4 t0[4], t1[4], t2[4];
#pragma unroll
        for (int j = 0; j < 4; ++j) { t0[j] = *(const f32x4*)(mp + 256 * j); t1[j] = *(const f32x4*)(mp + 1024 + 256 * j); t2[j] = *(const f32x4*)(gp + 256 * j); }
#pragma unroll
        for (int j = 0; j < 4; ++j) { sh[j] = t0[j]; sc[j] = (t1[j] + 1.0f) * g[j]; gt[j] = (t2[j] + 1.0f) * coef; }
    }
    for (int m0 = mw0; m0 < mw0 + rows_per_wave; m0 += RPW) {
        f32x4 v[RPW][4]; u32x2 dw[RPW][4];
        if (mode == 1) {
#pragma unroll
            for (int i = 0; i < RPW; ++i)
#pragma unroll
                for (int j = 0; j < 4; ++j) v[i][j] = *(const f32x4*)(xin + (size_t)(m0 + i) * DM + 4 * lane + 256 * j);
        } else {
#pragma unroll
            for (int i = 0; i < RPW; ++i)
#pragma unroll
                for (int j = 0; j < 4; ++j) { const u32x2 xw = __builtin_nontemporal_load((const u32x2*)(xb + (size_t)(m0 + i) * DM + 4 * lane + 256 * j)); v[i][j] = (f32x4){bf_lo(xw.x), bf_hi(xw.x), bf_lo(xw.y), bf_hi(xw.y)}; }
        }
        if (dsub >= 0) {
#pragma unroll
            for (int i = 0; i < RPW; ++i)
#pragma unroll
                for (int j = 0; j < 4; ++j) dw[i][j] = __builtin_nontemporal_load((const u32x2*)(dsrc + (size_t)(m0 + i) * DM + 4 * lane + 256 * j));
#pragma unroll
            for (int j = 0; j < 4; ++j)
#pragma unroll
                for (int i = 0; i < RPW; ++i) { v[i][j][0] += gt[j][0] * bf_lo(dw[i][j].x); v[i][j][1] += gt[j][1] * bf_hi(dw[i][j].x); v[i][j][2] += gt[j][2] * bf_lo(dw[i][j].y); v[i][j][3] += gt[j][3] * bf_hi(dw[i][j].y); }
        }
        float ss[RPW];
#pragma unroll
        for (int i = 0; i < RPW; ++i) { float t = 0.f;
#pragma unroll
            for (int j = 0; j < 4; ++j) t += (v[i][j][0] * v[i][j][0] + v[i][j][1] * v[i][j][1]) + (v[i][j][2] * v[i][j][2] + v[i][j][3] * v[i][j][3]);
            ss[i] = t; }
        if (mode == 1 || (dsub >= 0 && mode != 3)) {
#pragma unroll
            for (int i = 0; i < RPW; ++i)
#pragma unroll
                for (int j = 0; j < 4; ++j) { u32x2 w; w.x = cvtpk(v[i][j][0], v[i][j][1]); w.y = cvtpk(v[i][j][2], v[i][j][3]); __builtin_nontemporal_store(w, (u32x2*)(xb + (size_t)(m0 + i) * DM + 4 * lane + 256 * j)); }
        }
#pragma unroll
        for (int o = 1; o < 64; o <<= 1) {
#pragma unroll
            for (int i = 0; i < RPW; ++i) ss[i] += __shfl_xor(ss[i], o);
        }
#pragma unroll
        for (int i = 0; i < RPW; ++i) {
            const int m = m0 + i;
            const float r = 1.0f / sqrtf(ss[i] * (1.0f / DM) + EPS);
            f32x4 hv[4];
#pragma unroll
            for (int j = 0; j < 4; ++j) hv[j] = (v[i][j] * r) * sc[j] + sh[j];
            if (mode == 3) {
#pragma unroll
                for (int j = 0; j < 4; ++j) *(f32x4*)(p->out + (size_t)m * DM + 4 * lane + 256 * j) = hv[j];
            } else {
#pragma unroll
                for (int j = 0; j < 4; ++j) { u32x2 w; w.x = cvtpk(hv[j][0], hv[j][1]); w.y = cvtpk(hv[j][2], hv[j][3]); *(u32x2*)(hout + (size_t)m * DM + 4 * lane + 256 * j) = w; }
            }
            if (mode == 2) {
                float d[8];
                const LAS float* wq = wfT + 4 * lane; asm volatile("" : "+v"(wq));
#pragma unroll
                for (int jj = 0; jj < 8; ++jj) { float s = 0.f;
#pragma unroll
                    for (int j = 0; j < 4; ++j) { const f32x4 w = *(const LAS f32x4*)(wq + jj * 1024 + 256 * j); s += (hv[j][0] * w[0] + hv[j][1] * w[1]) + (hv[j][2] * w[2] + hv[j][3] * w[3]); }
                    d[jj] = s; }
#pragma unroll
                for (int o = 1; o < 64; o <<= 1) {
#pragma unroll
                    for (int jj = 0; jj < 8; ++jj) d[jj] += __shfl_xor(d[jj], o);
                }
                if (lane < 8) { float dv = d[0];
#pragma unroll
                    for (int jj = 1; jj < 8; ++jj) dv = (lane == jj) ? d[jj] : dv;
                    const float z = dv + p->in[15][l * 8 + lane];
                    const float ls = -(fmaxf(-z, 0.f) + log1pf(__expf(-fabsf(z))));
                    ((float*)(p->ws + WS_LOGF))[((size_t)b * 8 + lane) * SEQ + (m & (SEQ - 1))] = ls; }
            }
        }
    }
    if (mode == 2) __syncthreads();
}

constexpr int RG_TC = 128;
constexpr int RG_RGX = 0;
constexpr int RG_XAB = 16768;
constexpr int RG_WAT = RG_XAB + 18432;
constexpr int RG_WXT = RG_WAT + 9216;
constexpr int RG_AS = RG_WXT + 9216;
constexpr int RG_US = RG_AS + 34816;
constexpr int RG_CARRY = RG_US + 34816;
constexpr int RG_HST = RG_CARRY + 4096;
static_assert(RG_HST + 512 <= LDS_BYTES, "rg lds");

DI void rg_unit(int l, int b, int n, LAS unsigned char* lds, int dry = 0) {
    const KP p = kparams();
    const int tid = opaque_tid(), lane = tid & 63, wid = __builtin_amdgcn_readfirstlane(tid >> 6);
    bf16_t* proj = (bf16_t*)(p->ws + WS_PROJ);
    const int c0 = n * 64;
    const float* convw = p->in[8] + (size_t)l * 4 * 1024; const float* convb = p->in[9] + (size_t)l * 1024;
    const float* wa = p->in[10] + ((size_t)l * 16 + n) * 4096; const float* wx = p->in[12] + ((size_t)l * 16 + n) * 4096;
    const float* ba = p->in[11] + (size_t)l * 1024 + c0; const float* bx = p->in[13] + (size_t)l * 1024 + c0; const float* lam = p->in[14] + (size_t)l * 1024 + c0;
    LAS bf16_t* rgx = (LAS bf16_t*)(lds + RG_RGX); LAS bf16_t* xab = (LAS bf16_t*)(lds + RG_XAB);
    LAS bf16_t* wat = (LAS bf16_t*)(lds + RG_WAT); LAS bf16_t* wxt = (LAS bf16_t*)(lds + RG_WXT);
    LAS float* As = (LAS float*)(lds + RG_AS); LAS float* Us = (LAS float*)(lds + RG_US);
    LAS float* carry = (LAS float*)(lds + RG_CARRY); LAS float* hst = (LAS float*)(lds + RG_HST);
    const size_t rowbase = (size_t)b * SEQ;
    const int pr0 = tid >> 3, pc = tid & 7;
    const bf16_t* xsrc = proj + rowbase * PP + c0 + pc * 8;
    u32x4 x0, x1, x2;
    { const u32x4 z4 = (u32x4){0u, 0u, 0u, 0u};
      x0 = (pr0 - 3 >= 0) ? *(const u32x4*)(xsrc + (size_t)(pr0 - 3) * PP) : z4;
      x1 = *(const u32x4*)(xsrc + (size_t)(pr0 + 64 - 3) * PP);
      x2 = z4; if (tid < 24) x2 = *(const u32x4*)(xsrc + (size_t)(pr0 + 128 - 3) * PP); }
    for (int i = tid; i < 4096; i += NTHR) { const int d = i >> 6, e = i & 63; wat[e * 72 + d] = f2bf(wa[i]); wxt[e * 72 + d] = f2bf(wx[i]); }
    if (tid < 128) hst[tid] = 0.f;
    const float cw0 = convw[c0 + lane], cw1 = convw[1024 + c0 + lane], cw2 = convw[2048 + c0 + lane], cw3 = convw[3072 + c0 + lane], cbv = convb[c0 + lane];
    float bae[4], bxe[4], spe[4];
#pragma unroll
    for (int ei = 0; ei < 4; ++ei) { const int e = 16 * ei + (lane & 15); bae[ei] = ba[e]; bxe[ei] = bx[e]; const float lm = lam[e];
        spe[ei] = -8.0f * (fmaxf(-lm, 0.f) + log1pf(__expf(-fabsf(lm)))); }
    *(LAS u32x4*)(rgx + pr0 * 64 + pc * 8) = x0; *(LAS u32x4*)(rgx + (pr0 + 64) * 64 + pc * 8) = x1; if (tid < 24) *(LAS u32x4*)(rgx + (pr0 + 128) * 64 + pc * 8) = x2;
    __syncthreads();
#define LDS_BAR() do { asm volatile("s_waitcnt lgkmcnt(0)" ::: "memory"); __builtin_amdgcn_s_barrier(); asm volatile("" ::: "memory"); } while (0)
    for (int ch = 0; ch < SEQ / RG_TC; ++ch) {
        const int t0 = ch * RG_TC;
        bf16_t* gp = proj + (rowbase + t0 + 16 * wid) * PP + 1024 + c0 + lane;
        unsigned gq[16];
#pragma unroll
        for (int s2 = 0; s2 < 16; ++s2) gq[s2] = gp[(size_t)s2 * PP];
        const bool more = ch + 1 < SEQ / RG_TC;
        if (more) { const bf16_t* xs = xsrc + (size_t)(t0 + RG_TC - 3) * PP;
            x0 = *(const u32x4*)(xs + (size_t)pr0 * PP); x1 = *(const u32x4*)(xs + (size_t)(pr0 + 64) * PP); if (tid < 24) x2 = *(const u32x4*)(xs + (size_t)(pr0 + 128) * PP); }
#pragma unroll 4
        for (int i = 0; i < 16; ++i) { const int t = wid + 8 * i;
            const float v0 = bf1(rgx[(t + 0) * 64 + lane]), v1 = bf1(rgx[(t + 1) * 64 + lane]), v2 = bf1(rgx[(t + 2) * 64 + lane]), v3 = bf1(rgx[(t + 3) * 64 + lane]);
            const float xa = cbv + cw0 * v0 + cw1 * v1 + cw2 * v2 + cw3 * v3;
            Us[t * 68 + lane] = xa; xab[t * 72 + lane] = f2bf(xa); }
        LDS_BAR();
        {
            const int row = lane & 15, quad = lane >> 4;
            const bf16x8 a0 = *(const LAS bf16x8*)(xab + (16 * wid + row) * 72 + quad * 8), a1 = *(const LAS bf16x8*)(xab + (16 * wid + row) * 72 + 32 + quad * 8);
#pragma unroll
            for (int ei = 0; ei < 4; ++ei) {
                const bf16x8 ba0 = *(const LAS bf16x8*)(wat + (16 * ei + row) * 72 + quad * 8), ba1 = *(const LAS bf16x8*)(wat + (16 * ei + row) * 72 + 32 + quad * 8);
                const bf16x8 bx0 = *(const LAS bf16x8*)(wxt + (16 * ei + row) * 72 + quad * 8), bx1 = *(const LAS bf16x8*)(wxt + (16 * ei + row) * 72 + 32 + quad * 8);
                f32x4 rr = (f32x4){0.f, 0.f, 0.f, 0.f}, ii = (f32x4){0.f, 0.f, 0.f, 0.f};
                rr = MFMA16(a0, ba0, rr); rr = MFMA16(a1, ba1, rr);
                ii = MFMA16(a0, bx0, ii); ii = MFMA16(a1, bx1, ii);
#pragma unroll
                for (int jj = 0; jj < 4; ++jj) { const int t = 16 * wid + quad * 4 + jj, e = 16 * ei + row;
                    const float r = sigmoidf(rr[jj] + bae[ei]), ig = sigmoidf(ii[jj] + bxe[ei]);
                    const float la = r * spe[ei];
                    const float a = fexp2(la * LOG2E);
                    const float x2l = 2.0f * la;
                    const float ser = -x2l * (1.0f + x2l * (0.5f + x2l * (0.16666667f + x2l * (0.041666668f + x2l * (0.0083333338f + x2l * 0.0013888889f)))));
                    const float om = (x2l > -0.5f) ? ser : (1.0f - a * a);
                    const float sq = sqrtf(om);
                    const float xa = Us[t * 68 + e];
                    Us[t * 68 + e] = sq * ig * xa; As[t * 68 + e] = a; }
            }
        }
        LDS_BAR();
        {
            float P = 1.f, H = 0.f;
#pragma unroll
            for (int s2 = 0; s2 < 16; ++s2) { const int t = 16 * wid + s2; const float a = As[t * 68 + lane], u = Us[t * 68 + lane]; H = a * H + u; P *= a; }
            carry[(wid * 64 + lane) * 2] = P; carry[(wid * 64 + lane) * 2 + 1] = H;
            if (more) { *(LAS u32x4*)(rgx + pr0 * 64 + pc * 8) = x0; *(LAS u32x4*)(rgx + (pr0 + 64) * 64 + pc * 8) = x1; if (tid < 24) *(LAS u32x4*)(rgx + (pr0 + 128) * 64 + pc * 8) = x2; }
        }
        LDS_BAR();
        {
            float h = hst[(ch & 1) * 64 + lane];
            for (int s2 = 0; s2 < wid; ++s2) h = carry[(s2 * 64 + lane) * 2] * h + carry[(s2 * 64 + lane) * 2 + 1];
#pragma unroll
            for (int s2 = 0; s2 < 16; ++s2) { const int t = 16 * wid + s2; const float a = As[t * 68 + lane], u = Us[t * 68 + lane]; h = a * h + u;
                const float gx = bf1((bf16_t)gq[s2]);
                const float y2 = 1.5957691216f * (gx + 0.044715f * gx * gx * gx);
                const float ge = gx * sigmoidf(y2);
                if (!dry) gp[(size_t)s2 * PP] = f2bf(ge * h); }
            if (wid == 7) hst[((ch + 1) & 1) * 64 + lane] = h;
        }
        LDS_BAR();
    }
}
#undef LDS_BAR

constexpr int AT_K = 0, AT_V = 18432, AT_BIAS = 36864, AT_SCAN = AT_BIAS + 8192;
DI int crow(int r, int h) { return (r & 3) + 8 * (r >> 2) + 4 * h; }
DI s16x4 vtr(const LAS unsigned char* pp) { typedef short v4i16_t __attribute__((ext_vector_type(4))); return __builtin_bit_cast(s16x4, __builtin_amdgcn_ds_read_tr16_b64_v4i16((LAS v4i16_t*)pp)); }

template <bool SB>
DI void attn_unit(int b, int h, int qb, LAS unsigned char* lds, int dry = 0) {
    const KP p = kparams();
    const int tid = opaque_tid(), lane = tid & 63, wid = __builtin_amdgcn_readfirstlane(tid >> 6), r32 = lane & 31, hi = lane >> 5;
    bf16_t* proj = (bf16_t*)(p->ws + WS_PROJ);
    const int colQ = (SB ? 2048 : 3584) + h * 64, colK = colQ + 512, colV = colQ + 1024;
    const size_t rowbase = (size_t)b * SEQ;
    const int qmin = qb * 256 + wid * 32, qmax = qmin + 31, qrow = qmin + r32;
    const int NT = 4 * (qb + 1);
    LAS float* bias = (LAS float*)(lds + AT_BIAS);
    bf16x8 qr[4];
    { const bf16_t* qp = proj + (rowbase + qrow) * PP + colQ + hi * 8;
#pragma unroll
      for (int d0 = 0; d0 < 4; ++d0) qr[d0] = *(const bf16x8*)(qp + d0 * 16); }
    const int srow = tid >> 3, sch = tid & 7;
    const bf16_t* kg = proj + (rowbase + srow) * PP + colK + sch * 8;
    const bf16_t* vg = proj + (rowbase + srow) * PP + colV + sch * 8;
    const int soff = srow * 144 + sch * 16;
    const int jfirst = SB ? NT - 1 : 0;
    const u32x4 kreg0 = *(const u32x4*)(kg + (size_t)jfirst * 64 * PP), vreg0 = *(const u32x4*)(vg + (size_t)jfirst * 64 * PP);
    if (!SB) {
        const float* lf = (const float*)(p->ws + WS_LOGF) + ((size_t)b * 8 + h) * SEQ;
        LAS float* scanw = (LAS float*)(lds + AT_SCAN);
        const int n = 256 * (qb + 1);
        f32x4 v = (f32x4){0.f, 0.f, 0.f, 0.f};
        if (4 * tid < n) v = *(const f32x4*)(lf + 4 * tid);
        const float s1 = v[0], s2 = s1 + v[1], s3 = s2 + v[2], s4 = s3 + v[3];
        float sc = s4;
#pragma unroll
        for (int o = 1; o < 64; o <<= 1) { const float t = __shfl_up(sc, o); if (lane >= o) sc += t; }
        if (lane == 63) scanw[wid] = sc;
        __syncthreads();
        float off = sc - s4;
        for (int w = 0; w < wid; ++w) off += scanw[w];
        if (4 * tid < n) { f32x4 o; o[0] = -(off + s1) * LOG2E; o[1] = -(off + s2) * LOG2E; o[2] = -(off + s3) * LOG2E; o[3] = -(off + s4) * LOG2E; *(LAS f32x4*)(bias + 4 * tid) = o; }
    }
    *(LAS u32x4*)(lds + AT_K + soff) = kreg0; *(LAS u32x4*)(lds + AT_V + soff) = vreg0;
    __syncthreads();
    f32x16 y0, y1;
#pragma unroll
    for (int i = 0; i < 16; ++i) { y0[i] = 0.f; y1[i] = 0.f; }
    float mrun = -INFINITY, lrun = 0.f, carry = 0.f;
    LAS unsigned* xflag = (LAS unsigned*)(lds + AT_SCAN + 64);
    for (int it = 0; it < NT; ++it) {
        const int j = SB ? NT - 1 - it : it, buf = it & 1;
        const bool more = it + 1 < NT; const int jn = SB ? j - 1 : j + 1;
        u32x4 kreg, vreg;
        if (more) { kreg = *(const u32x4*)(kg + (size_t)jn * 64 * PP); vreg = *(const u32x4*)(vg + (size_t)jn * 64 * PP); }
        if (64 * j <= qmax && !(SB && __all(carry > 160.0f))) {
            const LAS unsigned char* Kb = lds + AT_K + buf * 9216; const LAS unsigned char* Vb = lds + AT_V + buf * 9216;
            f32x16 p0, p1;
            if (SB) {
#pragma unroll
                for (int i = 0; i < 16; ++i) { p0[i] = 0.f; p1[i] = 0.f; }
            } else {
                const LAS float* bp = bias + 64 * j + 4 * hi;
#pragma unroll
                for (int g = 0; g < 4; ++g) { const f32x4 t0 = *(const LAS f32x4*)(bp + 8 * g), t1 = *(const LAS f32x4*)(bp + 32 + 8 * g);
                    p0[4 * g] = t0[0]; p0[4 * g + 1] = t0[1]; p0[4 * g + 2] = t0[2]; p0[4 * g + 3] = t0[3];
                    p1[4 * g] = t1[0]; p1[4 * g + 1] = t1[1]; p1[4 * g + 2] = t1[2]; p1[4 * g + 3] = t1[3]; }
            }
#pragma unroll
            for (int d0 = 0; d0 < 4; ++d0) {
                const bf16x8 k0 = *(const LAS bf16x8*)(Kb + r32 * 144 + d0 * 32 + hi * 16), k1 = *(const LAS bf16x8*)(Kb + (32 + r32) * 144 + d0 * 32 + hi * 16);
                p0 = MFMA32(k0, qr[d0], p0); p1 = MFMA32(k1, qr[d0], p1);
            }
            const bool band = (64 * j + 63 >= qmin);
            if (SB) {
                float c0[16], c1[16];
#pragma unroll
                for (int i = 0; i < 16; ++i) {
                    const float z0 = p0[i], z1 = p1[i];
                    float a0 = fmaxf(z0, 0.f) + flog2(1.f + fexp2(-fabsf(z0))), a1 = fmaxf(z1, 0.f) + flog2(1.f + fexp2(-fabsf(z1)));
                    if (band) { const int kv = 64 * j + crow(i, hi); if (kv >= qrow) a0 = 0.f; if (kv + 32 >= qrow) a1 = 0.f; }
                    c0[i] = a0; c1[i] = a1;
                }
                float pr[8], tg[8];
#pragma unroll
                for (int g = 0; g < 4; ++g) { const float s0 = (c0[4 * g] + c0[4 * g + 1]) + (c0[4 * g + 2] + c0[4 * g + 3]), s1 = (c1[4 * g] + c1[4 * g + 1]) + (c1[4 * g + 2] + c1[4 * g + 3]);
                    tg[g] = __shfl_xor(s0, 32); tg[4 + g] = __shfl_xor(s1, 32); pr[g] = s0 + tg[g]; pr[4 + g] = s1 + tg[4 + g]; }
                float ps = 0.f;
#pragma unroll
                for (int g = 7; g >= 0; --g) {
                    const float sufex = carry + ps + (hi == 0 ? tg[g] : 0.f);
                    if (g >= 4) { const int gi = 4 * (g - 4);
                        const float C3 = sufex + c1[gi + 3], C2_ = C3 + c1[gi + 2], C1 = C2_ + c1[gi + 1], C0 = C1 + c1[gi];
                        p1[gi + 3] = fexp2(p1[gi + 3] - C3); p1[gi + 2] = fexp2(p1[gi + 2] - C2_); p1[gi + 1] = fexp2(p1[gi + 1] - C1); p1[gi] = fexp2(p1[gi] - C0);
                    } else { const int gi = 4 * g;
                        const float C3 = sufex + c0[gi + 3], C2_ = C3 + c0[gi + 2], C1 = C2_ + c0[gi + 1], C0 = C1 + c0[gi];
                        p0[gi + 3] = fexp2(p0[gi + 3] - C3); p0[gi + 2] = fexp2(p0[gi + 2] - C2_); p0[gi + 1] = fexp2(p0[gi + 1] - C1); p0[gi] = fexp2(p0[gi] - C0);
                    }
                    ps += pr[g];
                }
                carry += ps;
                if (band) {
#pragma unroll
                    for (int i = 0; i < 16; ++i) { const int kv = 64 * j + crow(i, hi); if (kv >= qrow) p0[i] = 0.f; if (kv + 32 >= qrow) p1[i] = 0.f; }
                }
            } else {
                if (band) {
#pragma unroll
                    for (int i = 0; i < 16; ++i) { const int kv = 64 * j + crow(i, hi); if (kv > qrow) p0[i] = -INFINITY; if (kv + 32 > qrow) p1[i] = -INFINITY; }
                }
                float rm = __builtin_fmaxf(p0[0], p1[0]), rm2 = __builtin_fmaxf(p0[1], p1[1]);
#pragma unroll
                for (int i = 2; i < 16; i += 2) { rm = __builtin_fmaxf(__builtin_fmaxf(rm, p0[i]), p1[i]); rm2 = __builtin_fmaxf(__builtin_fmaxf(rm2, p0[i + 1]), p1[i + 1]); }
                rm = __builtin_fmaxf(rm, rm2);
                rm = fmaxf(rm, __shfl_xor(rm, 32));
                if (__any(rm > mrun + 8.0f)) {
                    const float mnew = fmaxf(mrun, rm);
                    const float alpha = fexp2(mrun - mnew);
                    mrun = mnew; lrun *= alpha;
#pragma unroll
                    for (int i = 0; i < 16; ++i) { y0[i] *= alpha; y1[i] *= alpha; }
                }
                float rs = 0.f;
#pragma unroll
                for (int i = 0; i < 16; ++i) { p0[i] = fexp2(p0[i] - mrun); p1[i] = fexp2(p1[i] - mrun); rs += p0[i] + p1[i]; }
                lrun += rs;
            }
            const LAS unsigned char* vb = Vb + (4 * hi + ((lane & 15) >> 2)) * 144 + (16 * ((lane >> 4) & 1) + 4 * (lane & 3)) * 2;
#pragma unroll
            for (int pq = 0; pq < 2; ++pq)
#pragma unroll
                for (int ss = 0; ss < 2; ++ss) {
                    u32x4 pw;
                    if (pq == 0) { pw.x = cvtpk(p0[8 * ss], p0[8 * ss + 1]); pw.y = cvtpk(p0[8 * ss + 2], p0[8 * ss + 3]); pw.z = cvtpk(p0[8 * ss + 4], p0[8 * ss + 5]); pw.w = cvtpk(p0[8 * ss + 6], p0[8 * ss + 7]); }
                    else { pw.x = cvtpk(p1[8 * ss], p1[8 * ss + 1]); pw.y = cvtpk(p1[8 * ss + 2], p1[8 * ss + 3]); pw.z = cvtpk(p1[8 * ss + 4], p1[8 * ss + 5]); pw.w = cvtpk(p1[8 * ss + 6], p1[8 * ss + 7]); }
                    const bf16x8 xs = __builtin_bit_cast(bf16x8, pw);
                    const LAS unsigned char* vr = vb + (32 * pq + 16 * ss) * 144;
                    const s16x4 l0 = vtr(vr), h0 = vtr(vr + 8 * 144), l1 = vtr(vr + 64), h1 = vtr(vr + 8 * 144 + 64);
                    const bf16x8 pa0 = __builtin_shufflevector(l0, h0, 0, 1, 2, 3, 4, 5, 6, 7), pa1 = __builtin_shufflevector(l1, h1, 0, 1, 2, 3, 4, 5, 6, 7);
                    y0 = MFMA32(pa0, xs, y0); y1 = MFMA32(pa1, xs, y1);
                }
        }
        if (more) { *(LAS u32x4*)(lds + AT_K + (buf ^ 1) * 9216 + soff) = kreg; *(LAS u32x4*)(lds + AT_V + (buf ^ 1) * 9216 + soff) = vreg; }
        if (SB) {
            const bool sat = __all(carry > 160.0f);
            if (lane == 0) xflag[buf * 8 + wid] = sat ? 1u : 0u;
        }
        __syncthreads();
        if (SB) {
            unsigned allsat = 1u;
#pragma unroll
            for (int w = 0; w < 8; ++w) allsat &= xflag[buf * 8 + w];
            if (allsat) break;
        }
    }
    float inv = 1.f;
    if (!SB) { const float lt = lrun + __shfl_xor(lrun, 32); inv = 1.0f / lt; }
    bf16_t* op = proj + (rowbase + qrow) * PP + colQ + 4 * hi;
#pragma unroll
    for (int g = 0; g < 4; ++g) {
        u32x2 w0, w1;
        w0.x = cvtpk(y0[4 * g] * inv, y0[4 * g + 1] * inv); w0.y = cvtpk(y0[4 * g + 2] * inv, y0[4 * g + 3] * inv);
        w1.x = cvtpk(y1[4 * g] * inv, y1[4 * g + 1] * inv); w1.y = cvtpk(y1[4 * g + 2] * inv, y1[4 * g + 3] * inv);
        if (!dry) { *(u32x2*)(op + 8 * g) = w0; *(u32x2*)(op + 32 + 8 * g) = w1; }
    }
}


#define XB_TMO      128
#define XB_XCNT(j)  (256  + 64 * (j))
#define XB_XSUB(j)  (1280 + 64 * (j))
#define XB_XGEN(j)  (2304 + 64 * (j))
#define XB_TOP      3328
#define XB_TOPGEN   3392
#define XCD_BAR_WORDS 3456
#define XB_SPIN_CAP (1u << 18)
DI unsigned xb_ld(unsigned* p)              { return __hip_atomic_load(p, __ATOMIC_RELAXED, __HIP_MEMORY_SCOPE_AGENT); }
DI unsigned xb_add(unsigned* p, unsigned v) { return __hip_atomic_fetch_add(p, v, __ATOMIC_RELAXED, __HIP_MEMORY_SCOPE_AGENT); }
DI unsigned xb_xcc_id() { return (unsigned)__builtin_amdgcn_s_getreg((3 << 11) | 20) & 0xFu; }
#define XB_SPIN(cond, bar) do { unsigned _sp = 0; while (cond) { __builtin_amdgcn_s_sleep(1); \
    if ((++_sp & 255u) == 0u) { if (xb_ld(&(bar)[XB_TMO])) break; if (_sp > XB_SPIN_CAP) { atomicAdd(&(bar)[XB_TMO], 1u); break; } } } } while (0)
struct XcdBarrier { unsigned* bar; unsigned x; volatile LAS unsigned* st; };
DI XcdBarrier xcd_barrier_post(unsigned* bar, volatile LAS unsigned* st) {
    XcdBarrier b; b.bar = bar; b.x = xb_xcc_id(); b.st = st;
    if (threadIdx.x == 0) (void)xb_add(&bar[XB_XCNT(b.x)], 1u);
    return b;
}
DI void xcd_barrier_complete(unsigned* bar, unsigned x, unsigned& nloc, unsigned& nx) {
    const unsigned G = gridDim.x * gridDim.y * gridDim.z;
    unsigned sum, cnt, mine, sp = 0u;
    for (;;) {
        sum = 0u; cnt = 0u; mine = 0u;
#pragma unroll
        for (unsigned j = 0; j < 16; ++j) { const unsigned c = xb_ld(&bar[XB_XCNT(j)]); sum += c; cnt += (c > 0u) ? 1u : 0u; mine = (j == x) ? c : mine; }
        if (sum == G) break;
        __builtin_amdgcn_s_sleep(1);
        if ((++sp & 255u) == 0u) { if (xb_ld(&bar[XB_TMO])) break; if (sp > XB_SPIN_CAP) { atomicAdd(&bar[XB_TMO], 1u); break; } }
    }
    nloc = mine > 0u ? mine : 1u; nx = cnt > 0u ? cnt : 1u;
}
DI void xcd_barrier(const XcdBarrier& b) {
    asm volatile("s_waitcnt vmcnt(0)" ::: "memory");
    __syncthreads();
    if (threadIdx.x == 0) {
        unsigned* bar = b.bar;
        __builtin_amdgcn_s_waitcnt(0);
        unsigned nloc = b.st[0], nx = b.st[1];
        if (nloc == 0u) { xcd_barrier_complete(bar, b.x, nloc, nx); b.st[0] = nloc; b.st[1] = nx; }
        const unsigned old = xb_add(&bar[XB_XSUB(b.x)], 1u);
        const unsigned gen = old / nloc;
        if (old + 1u == (gen + 1u) * nloc) {
            __builtin_amdgcn_fence(__ATOMIC_RELEASE, "agent");
            asm volatile("s_waitcnt vmcnt(0)" ::: "memory");
            const unsigned og = xb_add(&bar[XB_TOP], 1u);
            const unsigned tg = og / nx;
            if (og + 1u == (tg + 1u) * nx) xb_add(&bar[XB_TOPGEN], 1u);
            else XB_SPIN(xb_ld(&bar[XB_TOPGEN]) == tg, bar);
            __builtin_amdgcn_fence(__ATOMIC_ACQUIRE, "agent");
            xb_add(&bar[XB_XGEN(b.x)], 1u);
            asm volatile("s_waitcnt vmcnt(0)" ::: "memory");
        } else {
            XB_SPIN(xb_ld(&bar[XB_XGEN(b.x)]) == gen, bar);
            __builtin_amdgcn_fence(__ATOMIC_ACQUIRE, "agent");
            asm volatile("s_waitcnt vmcnt(0)" ::: "memory");
        }
    }
    __syncthreads();
}

template <int KIND>
DI void run_gemm(LAS unsigned char* lds, int l, int ffn, int c, int sub, int dry = 0) {
    const KP p = kparams();
    unsigned char* ws = p->ws;
    pg8::EpiCtx E; E.hid = (bf16_t*)(ws + WS_HID); E.proj = (bf16_t*)(ws + WS_PROJ); E.hbuf = (KIND == 1 && l == 1 && ffn == 1) ? (bf16_t*)(ws + WS_DLAST) : (bf16_t*)p->out;
    E.mod = (const float*)(ws + WS_MOD) + (size_t)l * NB * NADA; E.merge_b = p->in[16] + (size_t)l * 3072;
    E.gscr = (bf16_t*)(ws + WS_GSCR) + (size_t)blockIdx.x * 65536; E.dry = dry;
    pg8::Sched S; S.kind = KIND; S.G = gridDim.x; S.c = c; S.sub = sub; S.A1 = nullptr; S.B1 = nullptr;
    if (KIND == 0) { S.A0 = (const char*)p->out; S.B0 = (const char*)(ws + (ffn ? WS_WUP2 : WS_WUP1)); }
    else if (KIND == 1) { S.A0 = (const char*)(ws + WS_HID); S.B0 = (const char*)(ws + (ffn ? WS_WDN2 : WS_WDN1)); }
    else if (KIND == 2) { S.A0 = (const char*)p->out; S.B0 = (const char*)(ws + WS_WIN); }
    else if (KIND == 3) { S.A0 = (const char*)p->out; S.B0 = (const char*)(ws + WS_WG); }
    else if (KIND == 5) { S.A0 = (const char*)(ws + WS_PROJ); S.B0 = (const char*)(ws + WS_WM); }
    else { S.A0 = (const char*)(ws + WS_PROJ); S.B0 = (const char*)(ws + WS_WO); }
    pg8::gemm_phase(lds, S, E);
}

__global__ void __launch_bounds__(NTHR, 2) fwd_megakernel(Params p_unused) {
    extern __shared__ __attribute__((aligned(16))) unsigned char lds_raw[];
    LAS unsigned char* lds = (LAS unsigned char*)lds_raw;
    cg::grid_group grid = cg::this_grid();
    const int G = gridDim.x, bx = blockIdx.x;
    { const KP p = kparams(); unsigned* bw = (unsigned*)p->ws;
      if (bx == 0) for (int i = threadIdx.x; i < XCD_BAR_WORDS; i += NTHR) __hip_atomic_store(bw + i, 0u, __ATOMIC_RELAXED, __HIP_MEMORY_SCOPE_AGENT);
      if (threadIdx.x < 2) ((volatile LAS unsigned*)(lds + 131072))[threadIdx.x] = 0u; }
#define GW_ARGS (int)(bx * NWAVES + __builtin_amdgcn_readfirstlane(opaque_tid() >> 6)), G * NWAVES

#ifndef NFWD
#define NFWD 1
#endif
    XcdBarrier xbar; xbar.bar = nullptr; xbar.x = 0; xbar.st = nullptr;
    for (int fwd = 0; fwd < NFWD; ++fwd) {
    if (REP(0)) for (int u = bx; u < 160; u += G) ada_unit(u, lds);
    if (RUN(0)) for (int u = bx; u < 160; u += G) ada_unit(u, lds);
    if (REP(1)) convert_weights(0, lds, GW_ARGS);
    if (RUN(1)) convert_weights(0, lds, GW_ARGS);
    if (fwd == 0) { grid.sync(); xbar = xcd_barrier_post((unsigned*)kparams()->ws, (volatile LAS unsigned*)(lds + 131072)); }
    else { XcdBarrier b_ = xbar; b_.bar = (unsigned*)kparams()->ws; xcd_barrier(b_); }
#define SEAM() do { XcdBarrier b_ = xbar; b_.bar = (unsigned*)kparams()->ws; xcd_barrier(b_); if (REP(16)) xcd_barrier(b_); } while (0)

    for (int l = 0; l < 2; ++l) {
        if (REP(1)) if (l == 1) convert_weights(1, lds, GW_ARGS);
        if (REP(2)) if (l == 0) norm_phase(l, 1, 0, lds, GW_ARGS);
        if (RUN(1)) if (l == 1) convert_weights(1, lds, GW_ARGS);
        if (RUN(2)) { if (l == 0) norm_phase(l, 1, 0, lds, GW_ARGS); else norm_phase(l, 0, 0, lds, GW_ARGS, 2, 0); }
        SEAM();
        if (REP(3)) run_gemm<0>(lds, l, 0, bx, 0, 1);
        if (RUN(3)) run_gemm<0>(lds, l, 0, bx, 0);
        SEAM();
        if (REP(4)) run_gemm<1>(lds, l, 0, bx, 0, 1);
        if (RUN(4)) run_gemm<1>(lds, l, 0, bx, 0);
        SEAM();
        if (RUN(5)) norm_phase(l, 2, 1, lds, GW_ARGS, 0, l);
        SEAM();
        if (REP(6)) run_gemm<2>(lds, l, 0, bx, 0, 1);
        if (RUN(6)) run_gemm<2>(lds, l, 0, bx, 0);
        SEAM();
        if (REPM & 0x380) {
        for (int u = bx; u < 256 + 2048; u += G) {
            if (u < 256) { if (REP(7)) rg_unit(l, u >> 4, u & 15, lds, 1); }
            else { const int a = u - 256, lv = a >> 8, cc = a & 255, qb = 7 - lv, bh = cc >> 1; const int ty = (((0x99 >> qb) ^ cc) & 1) ? 0 : 1;
                if (ty == 0) { if (REP(8)) attn_unit<true>(bh >> 3, bh & 7, qb, lds, 1); } else { if (REP(9)) attn_unit<false>(bh >> 3, bh & 7, qb, lds, 1); } }
        }
        }
        for (int u = bx; u < 256 + 2048; u += G) {
            if (u < 256) { if (RUN(7)) rg_unit(l, u >> 4, u & 15, lds); }
            else { const int a = u - 256, lv = a >> 8, cc = a & 255, qb = 7 - lv, bh = cc >> 1;
                const int ty = (((0x99 >> qb) ^ cc) & 1) ? 0 : 1;
                if (ty == 0) { if (RUN(8)) attn_unit<true>(bh >> 3, bh & 7, qb, lds); } else { if (RUN(9)) attn_unit<false>(bh >> 3, bh & 7, qb, lds); } }
        }
        SEAM();
        if (RUN(10)) {
            for (int L = bx; L < 512; L += G)
                for (int j = 0; j < 3; ++j) { if (REP(10)) { run_gemm<3>(lds, l, 0, L, j, 1); run_gemm<5>(lds, l, 0, L, j, 1); } run_gemm<3>(lds, l, 0, L, j); run_gemm<5>(lds, l, 0, L, j); }
        }
        SEAM();
        if (REP(11)) run_gemm<4>(lds, l, 0, bx, 1, 1);
        if (RUN(11)) run_gemm<4>(lds, l, 0, bx, 1);
        SEAM();
        if (RUN(12)) norm_phase(l, 0, 2, lds, GW_ARGS, 1, l);
        SEAM();
        if (REP(13)) run_gemm<0>(lds, l, 1, bx, 0, 1);
        if (RUN(13)) run_gemm<0>(lds, l, 1, bx, 0);
        SEAM();
        if (REP(14)) run_gemm<1>(lds, l, 1, bx, 2, 1);
        if (RUN(14)) run_gemm<1>(lds, l, 1, bx, 2);
        SEAM();
    }
    if (RUN(15)) norm_phase(0, 3, 0, lds, GW_ARGS, 2, 1);
    if (fwd + 1 < NFWD) SEAM();
    }
}

extern "C" void kernel_launch(void* const* d_in, const int* in_sizes, int n_in, void* d_out, int out_size, void* d_ws, size_t ws_size, hipStream_t stream) {
    static int grid = 0;
    if (grid == 0) {
        if (n_in != 30 || out_size != M * DM || ws_size < WS_END) { fprintf(stderr, "kernel_launch: unexpected shapes (n_in %d out %d ws %zu)\n", n_in, out_size, ws_size); grid = -1; return; }
        int dev = 0, cus = 0, per_cu = 0;
        (void)hipGetDevice(&dev);
        (void)hipDeviceGetAttribute(&cus, hipDeviceAttributeMultiprocessorCount, dev);
        if (hipFuncSetAttribute((const void*)fwd_megakernel, hipFuncAttributeMaxDynamicSharedMemorySize, LDS_BYTES) != hipSuccess) { fprintf(stderr, "kernel_launch: hipFuncSetAttribute failed\n"); grid = -1; return; }
        if (hipOccupancyMaxActiveBlocksPerMultiprocessor(&per_cu, (const void*)fwd_megakernel, NTHR, LDS_BYTES) != hipSuccess || per_cu < 1) per_cu = 1;
        (void)hipGetLastError();
        grid = cus >= 256 ? 256 : cus;
        (void)per_cu;
    }
    if (grid < 0) return;
    Params p{};
    for (int i = 0; i < 30; ++i) p.in[i] = (const float*)d_in[i];
    p.out = (float*)d_out; p.ws = (unsigned char*)d_ws;
    void* args[] = {&p};
    hipError_t e = hipLaunchCooperativeKernel((const void*)fwd_megakernel, dim3(grid), dim3(NTHR), args, LDS_BYTES, stream);
    if (e != hipSuccess) fprintf(stderr, "cooperative launch failed: %s (grid %d)\n", hipGetErrorString(e), grid);
}
```

```cpp
#include <hip/hip_runtime.h>
#include <hip/hip_cooperative_groups.h>
#include <cstdio>
#include <cstdint>
namespace cg = cooperative_groups;
#ifndef SKIPM
#define SKIPM 0
#endif
#define RUN(bit) (fwd != 0 || !((SKIPM) >> (bit) & 1))
#ifndef REPM
#define REPM 0
#endif
#define REP(bit) (((REPM) >> (bit)) & 1)

#define LAS __attribute__((address_space(3)))
#define DI __device__ __forceinline__
typedef unsigned short bf16_t;
typedef short bf16x8 __attribute__((ext_vector_type(8)));
typedef short s16x4 __attribute__((ext_vector_type(4)));
typedef float f32x4 __attribute__((ext_vector_type(4)));
typedef float f32x16 __attribute__((ext_vector_type(16)));
typedef unsigned u32x4 __attribute__((ext_vector_type(4)));
typedef unsigned u32x2 __attribute__((ext_vector_type(2)));

constexpr int NB = 16, SEQ = 2048, DM = 1024, DFF = 2816, M = NB * SEQ, PP = 5120  , NADA = 9216;
constexpr int NWAVES = 8, NTHR = 512;
constexpr float EPS = 1e-6f;
constexpr float LOG2E = 1.4426950408889634f;
constexpr float C2 = 0.125f * LOG2E;
constexpr size_t MiB = 1u << 20;
constexpr size_t WS_MOD = 1 * MiB;
constexpr size_t WS_FM = WS_MOD + (size_t)2 * NB * NADA * 4;
constexpr size_t WS_LOGF = 3 * MiB;
constexpr size_t WS_GSCR = 4 * MiB;
constexpr size_t WS_WUP1 = 36 * MiB;
constexpr size_t WS_WDN1 = 47 * MiB;
constexpr size_t WS_WUP2 = 53 * MiB;
constexpr size_t WS_WDN2 = 64 * MiB;
constexpr size_t WS_WIN = 70 * MiB;
constexpr size_t WS_WG = 80 * MiB;
constexpr size_t WS_WM = 86 * MiB;
constexpr size_t WS_WO = 90 * MiB;
constexpr size_t WS_XB = 92 * MiB;
constexpr size_t WS_DLAST = 332 * MiB;
constexpr size_t WS_PROJ = 156 * MiB;
constexpr size_t WS_HID = 156 * MiB;
constexpr size_t WS_END = 476 * MiB;
constexpr int LDS_BYTES = 147456;

struct Params { const float* in[30]; float* out; unsigned char* ws; };
typedef const __attribute__((address_space(4))) Params* KP;
__device__ __forceinline__ KP kparams() { KP q = (KP)__builtin_amdgcn_kernarg_segment_ptr(); asm volatile("" : "+s"(q)); return q; }

DI unsigned cvtpk(float lo, float hi) { typedef float f2 __attribute__((ext_vector_type(2))); typedef __bf16 b2 __attribute__((ext_vector_type(2))); f2 v = {lo, hi}; b2 b = __builtin_convertvector(v, b2); return __builtin_bit_cast(unsigned, b); }
DI float bf_lo(unsigned w) { return __uint_as_float(w << 16); }
DI float bf_hi(unsigned w) { return __uint_as_float(w & 0xffff0000u); }
DI float bf1(bf16_t v) { return __uint_as_float(((unsigned)v) << 16); }
DI bf16_t f2bf(float f) { return (bf16_t)(cvtpk(f, 0.f) & 0xffffu); }
DI float fexp2(float x) { return __builtin_amdgcn_exp2f(x); }
DI float flog2(float x) { return __builtin_amdgcn_logf(x); }
DI float frcp(float x) { return __builtin_amdgcn_rcpf(x); }
DI float sigmoidf(float v) { return frcp(1.f + fexp2(-v * LOG2E)); }
DI int opaque_tid() { int t = threadIdx.x; asm volatile("" : "+v"(t)); return t; }
DI float wave_sum(float v) {
#pragma unroll
    for (int o = 1; o < 64; o <<= 1) v += __shfl_xor(v, o);
    return v;
}
#define MFMA32(a, b, c) __builtin_amdgcn_mfma_f32_32x32x16_bf16((a), (b), (c), 0, 0, 0)
#define MFMA16(a, b, c) __builtin_amdgcn_mfma_f32_16x16x32_bf16((a), (b), (c), 0, 0, 0)

namespace pg8 {
constexpr int BM = 256, BK = 64, HALF = 128, HTB = HALF * BK * 2, STAGE_BYTES = 8 * HTB, NXCD = 8, WGM = 8;
DI int lds_byte(int r, int c) { const int st = (r >> 4) * 2 + (c >> 5), rr = r & 15, cc = c & 31, ob = rr * 64 + cc * 2; return st * 1024 + (ob ^ (((ob >> 9) & 1) << 5)); }
DI void stage_rc(int b, int& R, int& C) { const int st = b / 1024, sb = b % 1024, swz = sb ^ (((sb >> 9) & 1) << 5); R = (st >> 1) * 16 + swz / 64; C = (st & 1) * 32 + (swz % 64) / 2; }
DI int perm32(int rho) { const int n = rho >> 4, i = rho & 15; return 8 * (i >> 2) + 4 * n + (i & 3); }

enum { MODE_SWIGLU = 0, MODE_RESID = 1, MODE_PROJ = 2, MODE_GATE = 3, MODE_BRANCH = 4 };
struct Unit { const char* A; const char* B; unsigned lda, ldb; int nt, mode, pm, pn, aux; };
struct EpiCtx { bf16_t* hid; bf16_t* proj; bf16_t* hbuf; const float* mod; const float* merge_b; bf16_t* gscr; int dry; };

DI void tile_loc(int L, int nM, int nN, int& pm, int& pn) {
    const int nig = WGM * nN, gid = L / nig, fm = gid * WGM, gsz = (nM - fm) < WGM ? (nM - fm) : WGM;
    pm = fm + ((L % nig) % gsz); pn = (L % nig) / gsz;
}
DI void tile_of(int L, int nM, int nN, int& pm, int& pn) {
    const int nwg = nM * nN; int wgid = L;
    { const int q = nwg / NXCD, r = nwg % NXCD, xcd = wgid % NXCD, off = wgid / NXCD; wgid = (xcd < r ? xcd * (q + 1) : r * (q + 1) + (xcd - r) * q) + off; }
    const int nig = WGM * nN, gid = wgid / nig, fm = gid * WGM, gsz = (nM - fm) < WGM ? (nM - fm) : WGM;
    pm = fm + ((wgid % nig) % gsz); pn = (wgid % nig) / gsz;
}

struct Sched {
    int kind, G, c, sub, nM, pmoff;
    const char *A0, *B0, *A1, *B1;
    DI bool next(int i, Unit& u) const {
        if (kind == 0) { const long L = (long)i * G + c; if (L >= nM * 22) return false; if (nM == 128) tile_of((int)L, 128, 22, u.pm, u.pn); else { tile_loc((int)L, nM, 22, u.pm, u.pn); u.pm += pmoff; }
            u.lda = 2048u; u.ldb = 2048u; u.A = A0 + (size_t)u.pm * 256 * 2048; u.B = B0 + (size_t)u.pn * 256 * 2048; u.nt = 16; u.mode = MODE_SWIGLU; u.aux = 0; return true; }
        if (kind == 1) { const long L = (long)i * G + c; if (L >= nM * 4) return false; if (nM == 128) tile_of((int)L, 128, 4, u.pm, u.pn); else { tile_loc((int)L, nM, 4, u.pm, u.pn); u.pm += pmoff; }
            u.lda = 5632u; u.ldb = 5632u; u.A = A0 + (size_t)u.pm * 256 * 5632; u.B = B0 + (size_t)u.pn * 256 * 5632; u.nt = 44; u.mode = MODE_RESID; u.aux = sub; return true; }
        if (kind == 2) { const long L = (long)i * G + c; if (L >= nM * 20) return false; if (nM == 128) tile_of((int)L, 128, 20, u.pm, u.pn); else { tile_loc((int)L, nM, 20, u.pm, u.pn); u.pm += pmoff; }
            u.lda = 2048u; u.ldb = 2048u; u.A = A0 + (size_t)u.pm * 256 * 2048; u.B = B0 + (size_t)u.pn * 256 * 2048; u.nt = 16; u.mode = MODE_PROJ; u.aux = 0; return true; }
        if (kind == 3) { if (i != 0) return false; if (nM == 128) tile_of(c, 128, 4, u.pm, u.pn); else { tile_loc(c, nM, 4, u.pm, u.pn); u.pm += pmoff; } const int j = sub; u.aux = j;
            u.lda = 2048u; u.ldb = 2048u; u.A = A0 + (size_t)u.pm * 256 * 2048; u.B = B0 + (size_t)(j * 1024 + u.pn * 256) * 2048; u.nt = 16; u.mode = MODE_GATE; return true; }
        if (kind == 5) { if (i != 0) return false; if (nM == 128) tile_of(c, 128, 4, u.pm, u.pn); else { tile_loc(c, nM, 4, u.pm, u.pn); u.pm += pmoff; } const int j = sub; u.aux = j;
            const int acol = (j == 0) ? 1024 : (j == 1 ? 2048 : 3584), kcol = (j == 0) ? 0 : (j == 1 ? 1024 : 1536);
            u.lda = PP * 2u; u.ldb = 4096u; u.A = A0 + (size_t)u.pm * 256 * (PP * 2) + acol * 2; u.B = B0 + (size_t)u.pn * 256 * 4096 + kcol * 2; u.nt = (j == 0) ? 16 : 8; u.mode = MODE_BRANCH; return true; }
        { const long L = (long)i * G + c; if (L >= nM * 4) return false; if (nM == 128) tile_of((int)L, 128, 4, u.pm, u.pn); else { tile_loc((int)L, nM, 4, u.pm, u.pn); u.pm += pmoff; }
            u.lda = PP * 2u; u.ldb = 2048u; u.A = A0 + (size_t)u.pm * 256 * (PP * 2); u.B = B0 + (size_t)u.pn * 256 * 2048; u.nt = 16; u.mode = MODE_RESID; u.aux = 1; return true; }
    }
};

DI void epilogue(const f32x4 (&acc)[2][2][4][2], const Unit& u, const EpiCtx& E, int tid, int wr, int wc, int fr, int fq) {
    const int row0 = u.pm * BM + wr * 64 + fr, colw = wc * 32 + 8 * fq;
    if (u.mode == MODE_SWIGLU) {
#pragma unroll
        for (int ai = 0; ai < 2; ++ai)
#pragma unroll
            for (int m = 0; m < 4; ++m) {
                bf16_t* rowp = E.hid + (size_t)(row0 + ai * HALF + m * 16) * DFF + u.pn * 128 + colw;
                float o[8];
#pragma unroll
                for (int n = 0; n < 2; ++n)
#pragma unroll
                    for (int e = 0; e < 4; ++e) { const float a = acc[ai][0][m][n][e], g = acc[ai][1][m][n][e]; o[4 * n + e] = a * sigmoidf(a) * g; }
                u32x4 w; w.x = cvtpk(o[0], o[1]); w.y = cvtpk(o[2], o[3]); w.z = cvtpk(o[4], o[5]); w.w = cvtpk(o[6], o[7]);
                *(u32x4*)rowp = w;
            }
    } else if (u.mode == MODE_RESID) {
#pragma unroll
        for (int ai = 0; ai < 2; ++ai)
#pragma unroll
            for (int m = 0; m < 4; ++m) {
                bf16_t* rowp = E.hbuf + (size_t)(row0 + ai * HALF + m * 16) * DM + u.pn * BM + colw;
#pragma unroll
                for (int bj = 0; bj < 2; ++bj) { const f32x4 v0 = acc[ai][bj][m][0], v1 = acc[ai][bj][m][1];
                    u32x4 w; w.x = cvtpk(v0[0], v0[1]); w.y = cvtpk(v0[2], v0[3]); w.z = cvtpk(v1[0], v1[1]); w.w = cvtpk(v1[2], v1[3]);
                    *(u32x4*)(rowp + bj * HALF) = w; }
            }
    } else if (u.mode == MODE_PROJ) {
        const float sc = (u.pn == 8 || u.pn == 9 || u.pn == 14 || u.pn == 15) ? C2 : 1.0f;
#pragma unroll
        for (int ai = 0; ai < 2; ++ai)
#pragma unroll
            for (int m = 0; m < 4; ++m) {
                bf16_t* rowp = E.proj + (size_t)(row0 + ai * HALF + m * 16) * PP + u.pn * BM + colw;
#pragma unroll
                for (int bj = 0; bj < 2; ++bj) { const f32x4 v0 = acc[ai][bj][m][0] * sc, v1 = acc[ai][bj][m][1] * sc;
                    u32x4 w; w.x = cvtpk(v0[0], v0[1]); w.y = cvtpk(v0[2], v0[3]); w.z = cvtpk(v1[0], v1[1]); w.w = cvtpk(v1[2], v1[3]);
                    *(u32x4*)(rowp + bj * HALF) = w; }
            }
    } else if (u.mode == MODE_GATE) {
        const float* bp = E.merge_b + u.aux * 1024 + u.pn * BM + colw;
        f32x4 bv[2][2];
#pragma unroll
        for (int bj = 0; bj < 2; ++bj)
#pragma unroll
            for (int n = 0; n < 2; ++n) bv[bj][n] = *(const f32x4*)(bp + bj * HALF + 4 * n);
#pragma unroll
        for (int ai = 0; ai < 2; ++ai)
#pragma unroll
            for (int m = 0; m < 4; ++m)
#pragma unroll
                for (int bj = 0; bj < 2; ++bj) { float o[8];
#pragma unroll
                    for (int n = 0; n < 2; ++n)
#pragma unroll
                        for (int e = 0; e < 4; ++e) o[4 * n + e] = sigmoidf(acc[ai][bj][m][n][e] + bv[bj][n][e]);
                    u32x4 w; w.x = cvtpk(o[0], o[1]); w.y = cvtpk(o[2], o[3]); w.z = cvtpk(o[4], o[5]); w.w = cvtpk(o[6], o[7]);
                    *(u32x4*)(E.gscr + ((size_t)(((ai * 4 + m) * 2 + bj) * NTHR) + tid) * 8) = w; }
    } else {
        const float dm = (E.dry && u.aux != 0) ? 0.0f : 1.0f;
#pragma unroll
        for (int ai = 0; ai < 2; ++ai)
#pragma unroll
            for (int m = 0; m < 4; ++m) {
                bf16_t* rowp = E.proj + (size_t)(row0 + ai * HALF + m * 16) * PP + u.pn * BM + colw;
#pragma unroll
                for (int bj = 0; bj < 2; ++bj) {
                    const u32x4 g = *(const u32x4*)(E.gscr + ((size_t)(((ai * 4 + m) * 2 + bj) * NTHR) + tid) * 8);
                    float o[8];
                    o[0] = dm * bf_lo(g.x) * acc[ai][bj][m][0][0]; o[1] = dm * bf_hi(g.x) * acc[ai][bj][m][0][1]; o[2] = dm * bf_lo(g.y) * acc[ai][bj][m][0][2]; o[3] = dm * bf_hi(g.y) * acc[ai][bj][m][0][3];
                    o[4] = dm * bf_lo(g.z) * acc[ai][bj][m][1][0]; o[5] = dm * bf_hi(g.z) * acc[ai][bj][m][1][1]; o[6] = dm * bf_lo(g.w) * acc[ai][bj][m][1][2]; o[7] = dm * bf_hi(g.w) * acc[ai][bj][m][1][3];
                    if (u.aux != 0) { const u32x4 q = *(const u32x4*)(rowp + bj * HALF);
                        o[0] += bf_lo(q.x); o[1] += bf_hi(q.x); o[2] += bf_lo(q.y); o[3] += bf_hi(q.y); o[4] += bf_lo(q.z); o[5] += bf_hi(q.z); o[6] += bf_lo(q.w); o[7] += bf_hi(q.w); }
                    u32x4 w; w.x = cvtpk(o[0], o[1]); w.y = cvtpk(o[2], o[3]); w.z = cvtpk(o[4], o[5]); w.w = cvtpk(o[6], o[7]);
                    *(u32x4*)(rowp + bj * HALF) = w; }
                asm volatile("" ::: "memory");
            }
    }
}

DI void gemm_phase(LAS unsigned char* lds, const Sched& S, const EpiCtx& E) {
    const int tid = opaque_tid(), wid = __builtin_amdgcn_readfirstlane(tid >> 6), lane = tid & 63, wr = wid >> 2, wc = wid & 3, fr = lane & 15, fq = lane >> 4;
    int R0, C0; stage_rc(tid * 16, R0, C0);
    const int Rb0 = (R0 & ~31) + perm32(R0 & 31);
    const size_t kstep = (size_t)(BK * 2);
    const unsigned ldsw = (unsigned)wid * 1024u;
    const int aoff = lds_byte(wr * 64 + fr, fq * 8), boff = lds_byte(wc * 32 + fr, fq * 8);
#define PG8_SA(b, h) (((b) * 2 + (h)) * HTB)
#define PG8_SB(b, h) ((4 + (b) * 2 + (h)) * HTB)
#define PG8_STAGE(bufoff, gbase, v0, ld) do { \
        __builtin_amdgcn_global_load_lds((const unsigned*)((const char*)(gbase) + (v0)), (LAS unsigned*)(lds + (bufoff) + ldsw), 16, 0, 0); \
        __builtin_amdgcn_global_load_lds((const unsigned*)((const char*)(gbase) + (size_t)(ld) * 64 + (v0)), (LAS unsigned*)(lds + (bufoff) + ldsw + 8192), 16, 0, 0); } while (0)
#define PG8_LDA(dst, b, h) do { _Pragma("unroll") for (int m = 0; m < 4; ++m) _Pragma("unroll") for (int k = 0; k < 2; ++k) dst[m][k] = *(const LAS bf16x8*)(lds + PG8_SA(b, h) + aoff + m * 2048 + k * 1024); } while (0)
#define PG8_LDB(dst, b, h) do { _Pragma("unroll") for (int n = 0; n < 2; ++n) _Pragma("unroll") for (int k = 0; k < 2; ++k) dst[n][k] = *(const LAS bf16x8*)(lds + PG8_SB(b, h) + boff + n * 2048 + k * 1024); } while (0)
#define PG8_MMA(ai, bj, At, Bt) do { __builtin_amdgcn_s_setprio(1); _Pragma("unroll") for (int m = 0; m < 4; ++m) _Pragma("unroll") for (int n = 0; n < 2; ++n) _Pragma("unroll") for (int k = 0; k < 2; ++k) \
        acc[ai][bj][m][n] = __builtin_amdgcn_mfma_f32_16x16x32_bf16(Bt[n][k], At[m][k], acc[ai][bj][m][n], 0, 0, 0); __builtin_amdgcn_s_setprio(0); } while (0)
#define PG8_WAIT_V(n) asm volatile("s_waitcnt vmcnt(" #n ")" ::: "memory")
#define PG8_WAIT_L(n) asm volatile("s_waitcnt lgkmcnt(" #n ")" ::: "memory")
#define PG8_BAR __builtin_amdgcn_s_barrier()
#define PG8_SCHED __builtin_amdgcn_sched_barrier(0)
    Unit cur, nxt; int ui = 0;
    if (!S.next(0, cur)) return;
    f32x4 acc[2][2][4][2];
#pragma unroll
    for (int a = 0; a < 2; ++a)
#pragma unroll
        for (int b = 0; b < 2; ++b)
#pragma unroll
            for (int m = 0; m < 4; ++m)
#pragma unroll
                for (int n = 0; n < 2; ++n) acc[a][b][m][n] = (f32x4){0.f, 0.f, 0.f, 0.f};
    bf16x8 At[4][2], B0[2][2], B1[2][2];
    const char* cA = cur.A; const char* cB = cur.B;
    unsigned vA0 = (unsigned)R0 * cur.lda + (unsigned)C0 * 2u, vB0 = (unsigned)Rb0 * cur.ldb + (unsigned)C0 * 2u;
    unsigned lA = cur.lda, lB = cur.ldb;
    size_t hA = (size_t)HALF * cur.lda, hB = (size_t)HALF * cur.ldb;
    PG8_STAGE(PG8_SB(0, 0), cB, vB0, lB); PG8_STAGE(PG8_SB(0, 1), cB + hB, vB0, lB); PG8_STAGE(PG8_SA(0, 0), cA, vA0, lA); PG8_STAGE(PG8_SA(0, 1), cA + hA, vA0, lA);
    if (wr == 1) PG8_BAR;
    PG8_WAIT_V(2); PG8_BAR;
    PG8_STAGE(PG8_SB(1, 0), cB + kstep, vB0, lB); PG8_STAGE(PG8_SA(1, 0), cA + kstep, vA0, lA); PG8_STAGE(PG8_SB(1, 1), cB + hB + kstep, vB0, lB);
    PG8_WAIT_V(6); PG8_BAR;
    for (;;) {
        const bool has_next = S.next(ui + 1, nxt);
        const char* nA = has_next ? nxt.A : cA; const char* nB = has_next ? nxt.B : cB;
        const unsigned nlda = has_next ? nxt.lda : cur.lda, nldb = has_next ? nxt.ldb : cur.ldb;
        const unsigned nvA0 = (unsigned)R0 * nlda + (unsigned)C0 * 2u, nvB0 = (unsigned)Rb0 * nldb + (unsigned)C0 * 2u;
        const size_t nhA = (size_t)HALF * nlda, nhB = (size_t)HALF * nldb;
        const int nt = cur.nt;
        for (int t = 0; t < nt; t += 2) {
            const bool last = (t == nt - 2);
            const char* a1 = cA + (size_t)(t + 1) * kstep;
            const char* a2 = last ? nA : cA + (size_t)(t + 2) * kstep; const char* b2 = last ? nB : cB + (size_t)(t + 2) * kstep;
            const char* a3 = a2 + kstep; const char* b3 = b2 + kstep;
            const unsigned xA0 = last ? nvA0 : vA0, xB0 = last ? nvB0 : vB0, xlA = last ? nlda : lA, xlB = last ? nldb : lB;
            const size_t xhA = last ? nhA : hA, xhB = last ? nhB : hB;
            PG8_LDB(B0, 0, 0); PG8_LDB(B1, 0, 1); PG8_SCHED; PG8_LDA(At, 0, 0); PG8_STAGE(PG8_SA(1, 1), a1 + hA, vA0, lA);
            PG8_WAIT_V(8); PG8_WAIT_L(0); PG8_BAR; PG8_MMA(0, 0, At, B0); PG8_MMA(0, 1, At, B1); PG8_BAR; PG8_SCHED;
            PG8_LDA(At, 0, 1); PG8_STAGE(PG8_SB(0, 0), b2, xB0, xlB); PG8_STAGE(PG8_SB(0, 1), b2 + xhB, xB0, xlB); PG8_STAGE(PG8_SA(0, 0), a2, xA0, xlA);
            PG8_WAIT_V(8); PG8_WAIT_L(0); PG8_BAR; PG8_MMA(1, 0, At, B0); PG8_MMA(1, 1, At, B1); PG8_BAR; PG8_SCHED;
            PG8_LDB(B0, 1, 0); PG8_LDB(B1, 1, 1); PG8_SCHED; PG8_LDA(At, 1, 0); PG8_STAGE(PG8_SA(0, 1), a2 + xhA, xA0, xlA);
            PG8_WAIT_V(8); PG8_WAIT_L(0); PG8_BAR; PG8_MMA(0, 0, At, B0); PG8_MMA(0, 1, At, B1); PG8_BAR; PG8_SCHED;
            PG8_LDA(At, 1, 1); PG8_STAGE(PG8_SB(1, 0), b3, xB0, xlB); PG8_STAGE(PG8_SB(1, 1), b3 + xhB, xB0, xlB); PG8_STAGE(PG8_SA(1, 0), a3, xA0, xlA);
            PG8_WAIT_V(8); PG8_WAIT_L(0); PG8_BAR; PG8_MMA(1, 0, At, B0); PG8_MMA(1, 1, At, B1); PG8_BAR; PG8_SCHED;
        }
        if (wr == 0) PG8_BAR;
        epilogue(acc, cur, E, tid, wr, wc, fr, fq);
        if (!has_next) break;
#pragma unroll
        for (int a = 0; a < 2; ++a)
#pragma unroll
            for (int b = 0; b < 2; ++b)
#pragma unroll
                for (int m = 0; m < 4; ++m)
#pragma unroll
                    for (int n = 0; n < 2; ++n) acc[a][b][m][n] = (f32x4){0.f, 0.f, 0.f, 0.f};
        cur = nxt; cA = nA; cB = nB; vA0 = nvA0; vB0 = nvB0; lA = nlda; lB = nldb; hA = nhA; hB = nhB; ++ui;
        if (wr == 1) PG8_BAR;
    }
    PG8_WAIT_V(0);
    PG8_BAR;
#undef PG8_SA
#undef PG8_SB
#undef PG8_STAGE
#undef PG8_LDA
#undef PG8_LDB
#undef PG8_MMA
#undef PG8_WAIT_V
#undef PG8_WAIT_L
#undef PG8_BAR
#undef PG8_SCHED
}
}

DI void tr_item(const float* src, int srcP, int srcCol, int k0, bf16_t* dst, int dstP, int dstRow, int dstK, LAS float* scr, int lane) {
    float tv[32];
#pragma unroll
    for (int i = 0; i < 32; ++i) { const int kk = 2 * i + (lane >> 5); tv[i] = __builtin_nontemporal_load(src + (size_t)(k0 + kk) * srcP + srcCol + (lane & 31)); }
#pragma unroll
    for (int i = 0; i < 32; ++i) { const int kk = 2 * i + (lane >> 5); scr[kk * 33 + (lane & 31)] = tv[i]; }
    asm volatile("s_waitcnt lgkmcnt(0)" ::: "memory");
    const int c = lane & 7;
#pragma unroll
    for (int j = 0; j < 4; ++j) { const int n = (lane >> 3) + 8 * j; const LAS float* s = scr + (8 * c) * 33 + n;
        u32x4 o; o.x = cvtpk(s[0 * 33], s[1 * 33]); o.y = cvtpk(s[2 * 33], s[3 * 33]); o.z = cvtpk(s[4 * 33], s[5 * 33]); o.w = cvtpk(s[6 * 33], s[7 * 33]);
        *(u32x4*)(dst + (size_t)(dstRow + n) * dstP + dstK + k0 + 8 * c) = o; }
    asm volatile("s_waitcnt lgkmcnt(0)" ::: "memory");
}
DI void tr_job(int r, const float* src, int srcP, int srcC, int N, bf16_t* dst, int dstP, int dstK, int upHalf, LAS float* scr, int lane) {
    const int nblk = N / 32, kb = r / nblk, nb = r - kb * nblk, n0 = nb * 32;
    const int dstRow = (upHalf >= 0) ? ((n0 >> 7) * 256 + upHalf * 128 + (n0 & 127)) : n0;
    tr_item(src, srcP, srcC + n0, kb * 64, dst, dstP, dstRow, dstK, scr, lane);
}
DI void convert_weights(int l, LAS unsigned char* lds, int gw, int ngw) {
    const KP p = kparams();
    const int lane = opaque_tid() & 63, wave = gw & 7;
    LAS float* scr = (LAS float*)(lds + wave * 16384);
    unsigned char* ws = p->ws;
    const float* w1a = p->in[3] + (size_t)l * DM * DFF; const float* w3a = p->in[4] + (size_t)l * DM * DFF; const float* w2a = p->in[5] + (size_t)l * DFF * DM;
    const float* w1b = p->in[22] + (size_t)l * DM * DFF; const float* w3b = p->in[23] + (size_t)l * DM * DFF; const float* w2b = p->in[24] + (size_t)l * DFF * DM;
    const float* win = p->in[7] + (size_t)l * DM * 8200;
    const float* wrg = p->in[17] + (size_t)l * 1024 * 1024; const float* wsb = p->in[18] + (size_t)l * 512 * 1024; const float* wfx = p->in[19] + (size_t)l * 512 * 1024;
    const float* wo = p->in[20] + (size_t)l * 1024 * 1024;
    constexpr int I_UP = 16 * 88, I_DN = 44 * 32, I_IN = 16 * 160, I_G = 16 * 96, I_RG = 16 * 32, I_SB = 8 * 32, I_O = 16 * 32;
    constexpr int NITEMS = 4 * I_UP + 2 * I_DN + I_IN + I_G + I_RG + 2 * I_SB + I_O;
    const int ipw = (NITEMS + ngw - 1) / ngw;
    for (int it = gw * ipw; it < (gw + 1) * ipw && it < NITEMS; ++it) {
        int r = it;
        if (r < I_UP) { tr_job(r, w1a, DFF, 0, DFF, (bf16_t*)(ws + WS_WUP1), 1024, 0, 0, scr, lane); continue; } r -= I_UP;
        if (r < I_UP) { tr_job(r, w3a, DFF, 0, DFF, (bf16_t*)(ws + WS_WUP1), 1024, 0, 1, scr, lane); continue; } r -= I_UP;
        if (r < I_DN) { tr_job(r, w2a, DM, 0, DM, (bf16_t*)(ws + WS_WDN1), DFF, 0, -1, scr, lane); continue; } r -= I_DN;
        if (r < I_UP) { tr_job(r, w1b, DFF, 0, DFF, (bf16_t*)(ws + WS_WUP2), 1024, 0, 0, scr, lane); continue; } r -= I_UP;
        if (r < I_UP) { tr_job(r, w3b, DFF, 0, DFF, (bf16_t*)(ws + WS_WUP2), 1024, 0, 1, scr, lane); continue; } r -= I_UP;
        if (r < I_DN) { tr_job(r, w2b, DM, 0, DM, (bf16_t*)(ws + WS_WDN2), DFF, 0, -1, scr, lane); continue; } r -= I_DN;
        if (r < I_IN) { tr_job(r, win, 8200, 0, 5120, (bf16_t*)(ws + WS_WIN), 1024, 0, -1, scr, lane); continue; } r -= I_IN;
        if (r < I_G) { tr_job(r, win, 8200, 5128, 3072, (bf16_t*)(ws + WS_WG), 1024, 0, -1, scr, lane); continue; } r -= I_G;
        if (r < I_RG) { tr_job(r, wrg, 1024, 0, 1024, (bf16_t*)(ws + WS_WM), 2048, 0, -1, scr, lane); continue; } r -= I_RG;
        if (r < I_SB) { tr_job(r, wsb, 1024, 0, 1024, (bf16_t*)(ws + WS_WM), 2048, 1024, -1, scr, lane); continue; } r -= I_SB;
        if (r < I_SB) { tr_job(r, wfx, 1024, 0, 1024, (bf16_t*)(ws + WS_WM), 2048, 1536, -1, scr, lane); continue; } r -= I_SB;
        tr_job(r, wo, 1024, 0, 1024, (bf16_t*)(ws + WS_WO), 1024, 0, -1, scr, lane);
    }
}

DI void ada_unit(int u, LAS unsigned char* lds) {
    const KP p = kparams();
    const int tid = opaque_tid();
    LAS float* cT = (LAS float*)lds;
    LAS float* red = (LAS float*)(lds + 65536);
    const float* c = p->in[1];
    for (int i = tid; i < NB * DM; i += NTHR) { const int b = i >> 10, k = i & 1023; const float v = c[i]; cT[k * 16 + b] = v * sigmoidf(v); }
    __syncthreads();
    const float* W; const float* bias; float* out; int pitch, j0;
    if (u < 144) { const int l = u / 72, uu = u - l * 72; j0 = uu * 128; pitch = NADA; W = p->in[25] + (size_t)l * DM * NADA; bias = p->in[26] + (size_t)l * NADA; out = (float*)(p->ws + WS_MOD) + (size_t)l * NB * NADA; }
    else { j0 = (u - 144) * 128; pitch = 2048; W = p->in[28]; bias = p->in[29]; out = (float*)(p->ws + WS_FM); }
    const int col = tid & 127, q = tid >> 7;
    float acc[16];
#pragma unroll
    for (int b = 0; b < 16; ++b) acc[b] = 0.f;
    const float* wp = W + (size_t)(q * 256) * pitch + j0 + col;
    for (int k0 = 0; k0 < 256; k0 += 16) {
        float wv[16];
#pragma unroll
        for (int kk = 0; kk < 16; ++kk) wv[kk] = __builtin_nontemporal_load(wp + (size_t)(k0 + kk) * pitch);
#pragma unroll
        for (int kk = 0; kk < 16; ++kk) {
            const float w = wv[kk];
            const LAS f32x4* cp = (const LAS f32x4*)(cT + (q * 256 + k0 + kk) * 16);
            const f32x4 c0 = cp[0], c1 = cp[1], c2 = cp[2], c3 = cp[3];
            acc[0] += c0[0] * w; acc[1] += c0[1] * w; acc[2] += c0[2] * w; acc[3] += c0[3] * w;
            acc[4] += c1[0] * w; acc[5] += c1[1] * w; acc[6] += c1[2] * w; acc[7] += c1[3] * w;
            acc[8] += c2[0] * w; acc[9] += c2[1] * w; acc[10] += c2[2] * w; acc[11] += c2[3] * w;
            acc[12] += c3[0] * w; acc[13] += c3[1] * w; acc[14] += c3[2] * w; acc[15] += c3[3] * w;
        }
    }
#pragma unroll
    for (int b = 0; b < 16; ++b) red[(q * 16 + b) * 128 + col] = acc[b];
    __syncthreads();
    for (int i = tid; i < 16 * 128; i += NTHR) { const int b = i >> 7, cc = i & 127;
        const float s = red[(0 * 16 + b) * 128 + cc] + red[(1 * 16 + b) * 128 + cc] + red[(2 * 16 + b) * 128 + cc] + red[(3 * 16 + b) * 128 + cc];
        out[(size_t)b * pitch + j0 + cc] = s + bias[j0 + cc]; }
    __syncthreads();
}

DI void norm_phase(int l, int mode, int sub, LAS unsigned char* lds, int gw, int ngw, int dsub = -1, int dl = 0) {
    const KP p = kparams();
    const int lane = opaque_tid() & 63;
    const float* xin = p->in[0];
    bf16_t* xb = (bf16_t*)(p->ws + WS_XB);
    const bf16_t* dsrc = (mode == 3) ? (const bf16_t*)(p->ws + WS_DLAST) : (const bf16_t*)p->out;
    const float* gain = (mode == 3) ? p->in[27] : ((sub == 0 ? p->in[2] : (sub == 1 ? p->in[6] : p->in[21])) + (size_t)l * DM);
    const float* mod = (mode == 3) ? (const float*)(p->ws + WS_FM) : ((const float*)(p->ws + WS_MOD) + (size_t)l * NB * NADA + sub * 3072);
    const int mpitch = (mode == 3) ? 2048 : NADA;
    bf16_t* hout = (bf16_t*)p->out;
    LAS float* wfT = (LAS float*)lds;
    if (mode == 2) {
        const float* win = p->in[7] + (size_t)l * DM * 8200 + 5120;
        for (int i = opaque_tid(); i < 8192; i += NTHR) { const int k = i >> 3, j = i & 7; wfT[j * 1024 + k] = win[(size_t)k * 8200 + j]; }
        __syncthreads();
    }
    f32x4 g[4];
#pragma unroll
    for (int j = 0; j < 4; ++j) g[j] = *(const f32x4*)(gain + 4 * lane + 256 * j);
    constexpr int RPW = 4;
    const int rows_per_wave = M / ngw;
    const int mw0 = gw * rows_per_wave, b = mw0 >> 11;
    f32x4 sh[4], sc[4], gt[4];
    {
        const float* mp = mod + (size_t)b * mpitch + 4 * lane;
        const float coef = (dsub == 1) ? 1.0f : 0.5f;
        const float* gp = (const float*)(p->ws + WS_MOD) + (size_t)dl * NB * NADA + (size_t)b * NADA + (dsub >= 0 ? dsub : 0) * 3072 + 2048 + 4 * lane;
        f32x4 t0[4], t1[4], t2[4];
#pragma unroll
        for (int j = 0; j < 4; ++j) { t0[j] = *(const f32x4*)(mp + 256 * j); t1[j] = *(const f32x4*)(mp + 1024 + 256 * j); t2[j] = *(const f32x4*)(gp + 256 * j); }
#pragma unroll
        for (int j = 0; j < 4; ++j) { sh[j] = t0[j]; sc[j] = (t1[j] + 1.0f) * g[j]; gt[j] = (t2[j] + 1.0f) * coef; }
    }
    for (int m0 = mw0; m0 < mw0 + rows_per_wave; m0 += RPW) {
        f32x4 v[RPW][4]; u32x2 dw[RPW][4];
        if (mode == 1) {
#pragma unroll
            for (int i = 0; i < RPW; ++i)
#pragma unroll
                for (int j = 0; j < 4; ++j) v[i][j] = *(const f32x4*)(xin + (size_t)(m0 + i) * DM + 4 * lane + 256 * j);
        } else {
#pragma unroll
            for (int i = 0; i < RPW; ++i)
#pragma unroll
                for (int j = 0; j < 4; ++j) { const u32x2 xw = __builtin_nontemporal_load((const u32x2*)(xb + (size_t)(m0 + i) * DM + 4 * lane + 256 * j)); v[i][j] = (f32x4){bf_lo(xw.x), bf_hi(xw.x), bf_lo(xw.y), bf_hi(xw.y)}; }
        }
        if (dsub >= 0) {
#pragma unroll
            for (int i = 0; i < RPW; ++i)
#pragma unroll
                for (int j = 0; j < 4; ++j) dw[i][j] = __builtin_nontemporal_load((const u32x2*)(dsrc + (size_t)(m0 + i) * DM + 4 * lane + 256 * j));
#pragma unroll
            for (int j = 0; j < 4; ++j)
#pragma unroll
                for (int i = 0; i < RPW; ++i) { v[i][j][0] += gt[j][0] * bf_lo(dw[i][j].x); v[i][j][1] += gt[j][1] * bf_hi(dw[i][j].x); v[i][j][2] += gt[j][2] * bf_lo(dw[i][j].y); v[i][j][3] += gt[j][3] * bf_hi(dw[i][j].y); }
        }
        float ss[RPW];
#pragma unroll
        for (int i = 0; i < RPW; ++i) { float t = 0.f;
#pragma unroll
            for (int j = 0; j < 4; ++j) t += (v[i][j][0] * v[i][j][0] + v[i][j][1] * v[i][j][1]) + (v[i][j][2] * v[i][j][2] + v[i][j][3] * v[i][j][3]);
            ss[i] = t; }
        if (mode == 1 || (dsub >= 0 && mode != 3)) {
#pragma unroll
            for (int i = 0; i < RPW; ++i)
#pragma unroll
                for (int j = 0; j < 4; ++j) { u32x2 w; w.x = cvtpk(v[i][j][0], v[i][j][1]); w.y = cvtpk(v[i][j][2], v[i][j][3]); __builtin_nontemporal_store(w, (u32x2*)(xb + (size_t)(m0 + i) * DM + 4 * lane + 256 * j)); }
        }
#pragma unroll
        for (int o = 1; o < 64; o <<= 1) {
#pragma unroll
            for (int i = 0; i < RPW; ++i) ss[i] += __shfl_xor(ss[i], o);
        }
#pragma unroll
        for (int i = 0; i < RPW; ++i) {
            const int m = m0 + i;
            const float r = 1.0f / sqrtf(ss[i] * (1.0f / DM) + EPS);
            f32x4 hv[4];
#pragma unroll
            for (int j = 0; j < 4; ++j) hv[j] = (v[i][j] * r) * sc[j] + sh[j];
            if (mode == 3) {
#pragma unroll
                for (int j = 0; j < 4; ++j) *(f32x4*)(p->out + (size_t)m * DM + 4 * lane + 256 * j) = hv[j];
            } else {
#pragma unroll
                for (int j = 0; j < 4; ++j) { u32x2 w; w.x = cvtpk(hv[j][0], hv[j][1]); w.y = cvtpk(hv[j][2], hv[j][3]); *(u32x2*)(hout + (size_t)m * DM + 4 * lane + 256 * j) = w; }
            }
            if (mode == 2) {
                float d[8];
                const LAS float* wq = wfT + 4 * lane; asm volatile("" : "+v"(wq));
#pragma unroll
                for (int jj = 0; jj < 8; ++jj) { float s = 0.f;
#pragma unroll
                    for (int j = 0; j < 4; ++j) { const f32x4 w = *(const LAS f32x4*)(wq + jj * 1024 + 256 * j); s += (hv[j][0] * w[0] + hv[j][1] * w[1]) + (hv[j][2] * w[2] + hv[j][3] * w[3]); }
                    d[jj] = s; }
#pragma unroll
                for (int o = 1; o < 64; o <<= 1) {
#pragma unroll
                    for (int jj = 0; jj < 8; ++jj) d[jj] += __shfl_xor(d[jj], o);
                }
                if (lane < 8) { float dv = d[0];
#pragma unroll
                    for (int jj = 1; jj < 8; ++jj) dv = (lane == jj) ? d[jj] : dv;
                    const float z = dv + p->in[15][l * 8 + lane];
                    const float ls = -(fmaxf(-z, 0.f) + log1pf(__expf(-fabsf(z))));
                    ((float*)(p->ws + WS_LOGF))[((size_t)b * 8 + lane) * SEQ + (m & (SEQ - 1))] = ls; }
            }
        }
    }
    if (mode == 2) __syncthreads();
}

constexpr int RG_TC = 128;
constexpr int RG_RGX = 0;
constexpr int RG_XAB = 16768;
constexpr int RG_WAT = RG_XAB + 18432;
constexpr int RG_WXT = RG_WAT + 9216;
constexpr int RG_AS = RG_WXT + 9216;
constexpr int RG_US = RG_AS + 34816;
constexpr int RG_CARRY = RG_US + 34816;
constexpr int RG_HST = RG_CARRY + 4096;
static_assert(RG_HST + 512 <= LDS_BYTES, "rg lds");

DI void rg_unit(int l, int b, int n, LAS unsigned char* lds, int dry = 0) {
    const KP p = kparams();
    const int tid = opaque_tid(), lane = tid & 63, wid = __builtin_amdgcn_readfirstlane(tid >> 6);
    bf16_t* proj = (bf16_t*)(p->ws + WS_PROJ);
    const int c0 = n * 64;
    const float* convw = p->in[8] + (size_t)l * 4 * 1024; const float* convb = p->in[9] + (size_t)l * 1024;
    const float* wa = p->in[10] + ((size_t)l * 16 + n) * 4096; const float* wx = p->in[12] + ((size_t)l * 16 + n) * 4096;
    const float* ba = p->in[11] + (size_t)l * 1024 + c0; const float* bx = p->in[13] + (size_t)l * 1024 + c0; const float* lam = p->in[14] + (size_t)l * 1024 + c0;
    LAS bf16_t* rgx = (LAS bf16_t*)(lds + RG_RGX); LAS bf16_t* xab = (LAS bf16_t*)(lds + RG_XAB);
    LAS bf16_t* wat = (LAS bf16_t*)(lds + RG_WAT); LAS bf16_t* wxt = (LAS bf16_t*)(lds + RG_WXT);
    LAS float* As = (LAS float*)(lds + RG_AS); LAS float* Us = (LAS float*)(lds + RG_US);
    LAS float* carry = (LAS float*)(lds + RG_CARRY); LAS float* hst = (LAS float*)(lds + RG_HST);
    const size_t rowbase = (size_t)b * SEQ;
    const int pr0 = tid >> 3, pc = tid & 7;
    const bf16_t* xsrc = proj + rowbase * PP + c0 + pc * 8;
    u32x4 x0, x1, x2;
    { const u32x4 z4 = (u32x4){0u, 0u, 0u, 0u};
      x0 = (pr0 - 3 >= 0) ? *(const u32x4*)(xsrc + (size_t)(pr0 - 3) * PP) : z4;
      x1 = *(const u32x4*)(xsrc + (size_t)(pr0 + 64 - 3) * PP);
      x2 = z4; if (tid < 24) x2 = *(const u32x4*)(xsrc + (size_t)(pr0 + 128 - 3) * PP); }
    for (int i = tid; i < 4096; i += NTHR) { const int d = i >> 6, e = i & 63; wat[e * 72 + d] = f2bf(wa[i]); wxt[e * 72 + d] = f2bf(wx[i]); }
    if (tid < 128) hst[tid] = 0.f;
    const float cw0 = convw[c0 + lane], cw1 = convw[1024 + c0 + lane], cw2 = convw[2048 + c0 + lane], cw3 = convw[3072 + c0 + lane], cbv = convb[c0 + lane];
    float bae[4], bxe[4], spe[4];
#pragma unroll
    for (int ei = 0; ei < 4; ++ei) { const int e = 16 * ei + (lane & 15); bae[ei] = ba[e]; bxe[ei] = bx[e]; const float lm = lam[e];
        spe[ei] = -8.0f * (fmaxf(-lm, 0.f) + log1pf(__expf(-fabsf(lm)))); }
    *(LAS u32x4*)(rgx + pr0 * 64 + pc * 8) = x0; *(LAS u32x4*)(rgx + (pr0 + 64) * 64 + pc * 8) = x1; if (tid < 24) *(LAS u32x4*)(rgx + (pr0 + 128) * 64 + pc * 8) = x2;
    __syncthreads();
#define LDS_BAR() do { asm volatile("s_waitcnt lgkmcnt(0)" ::: "memory"); __builtin_amdgcn_s_barrier(); asm volatile("" ::: "memory"); } while (0)
    for (int ch = 0; ch < SEQ / RG_TC; ++ch) {
        const int t0 = ch * RG_TC;
        bf16_t* gp = proj + (rowbase + t0 + 16 * wid) * PP + 1024 + c0 + lane;
        unsigned gq[16];
#pragma unroll
        for (int s2 = 0; s2 < 16; ++s2) gq[s2] = gp[(size_t)s2 * PP];
        const bool more = ch + 1 < SEQ / RG_TC;
        if (more) { const bf16_t* xs = xsrc + (size_t)(t0 + RG_TC - 3) * PP;
            x0 = *(const u32x4*)(xs + (size_t)pr0 * PP); x1 = *(const u32x4*)(xs + (size_t)(pr0 + 64) * PP); if (tid < 24) x2 = *(const u32x4*)(xs + (size_t)(pr0 + 128) * PP); }
#pragma unroll 4
        for (int i = 0; i < 16; ++i) { const int t = wid + 8 * i;
            const float v0 = bf1(rgx[(t + 0) * 64 + lane]), v1 = bf1(rgx[(t + 1) * 64 + lane]), v2 = bf1(rgx[(t + 2) * 64 + lane]), v3 = bf1(rgx[(t + 3) * 64 + lane]);
            const float xa = cbv + cw0 * v0 + cw1 * v1 + cw2 * v2 + cw3 * v3;
            Us[t * 68 + lane] = xa; xab[t * 72 + lane] = f2bf(xa); }
        LDS_BAR();
        {
            const int row = lane & 15, quad = lane >> 4;
            const bf16x8 a0 = *(const LAS bf16x8*)(xab + (16 * wid + row) * 72 + quad * 8), a1 = *(const LAS bf16x8*)(xab + (16 * wid + row) * 72 + 32 + quad * 8);
#pragma unroll
            for (int ei = 0; ei < 4; ++ei) {
                const bf16x8 ba0 = *(const LAS bf16x8*)(wat + (16 * ei + row) * 72 + quad * 8), ba1 = *(const LAS bf16x8*)(wat + (16 * ei + row) * 72 + 32 + quad * 8);
                const bf16x8 bx0 = *(const LAS bf16x8*)(wxt + (16 * ei + row) * 72 + quad * 8), bx1 = *(const LAS bf16x8*)(wxt + (16 * ei + row) * 72 + 32 + quad * 8);
                f32x4 rr = (f32x4){0.f, 0.f, 0.f, 0.f}, ii = (f32x4){0.f, 0.f, 0.f, 0.f};
                rr = MFMA16(a0, ba0, rr); rr = MFMA16(a1, ba1, rr);
                ii = MFMA16(a0, bx0, ii); ii = MFMA16(a1, bx1, ii);
#pragma unroll
                for (int jj = 0; jj < 4; ++jj) { const int t = 16 * wid + quad * 4 + jj, e = 16 * ei + row;
                    const float r = sigmoidf(rr[jj] + bae[ei]), ig = sigmoidf(ii[jj] + bxe[ei]);
                    const float la = r * spe[ei];
                    const float a = fexp2(la * LOG2E);
                    const float x2l = 2.0f * la;
                    const float ser = -x2l * (1.0f + x2l * (0.5f + x2l * (0.16666667f + x2l * (0.041666668f + x2l * (0.0083333338f + x2l * 0.0013888889f)))));
                    const float om = (x2l > -0.5f) ? ser : (1.0f - a * a);
                    const float sq = sqrtf(om);
                    const float xa = Us[t * 68 + e];
                    Us[t * 68 + e] = sq * ig * xa; As[t * 68 + e] = a; }
            }
        }
        LDS_BAR();
        {
            float P = 1.f, H = 0.f;
#pragma unroll
            for (int s2 = 0; s2 < 16; ++s2) { const int t = 16 * wid + s2; const float a = As[t * 68 + lane], u = Us[t * 68 + lane]; H = a * H + u; P *= a; }
            carry[(wid * 64 + lane) * 2] = P; carry[(wid * 64 + lane) * 2 + 1] = H;
            if (more) { *(LAS u32x4*)(rgx + pr0 * 64 + pc * 8) = x0; *(LAS u32x4*)(rgx + (pr0 + 64) * 64 + pc * 8) = x1; if (tid < 24) *(LAS u32x4*)(rgx + (pr0 + 128) * 64 + pc * 8) = x2; }
        }
        LDS_BAR();
        {
            float h = hst[(ch & 1) * 64 + lane];
            for (int s2 = 0; s2 < wid; ++s2) h = carry[(s2 * 64 + lane) * 2] * h + carry[(s2 * 64 + lane) * 2 + 1];
#pragma unroll
            for (int s2 = 0; s2 < 16; ++s2) { const int t = 16 * wid + s2; const float a = As[t * 68 + lane], u = Us[t * 68 + lane]; h = a * h + u;
                const float gx = bf1((bf16_t)gq[s2]);
                const float y2 = 1.5957691216f * (gx + 0.044715f * gx * gx * gx);
                const float ge = gx * sigmoidf(y2);
                if (!dry) gp[(size_t)s2 * PP] = f2bf(ge * h); }
            if (wid == 7) hst[((ch + 1) & 1) * 64 + lane] = h;
        }
        LDS_BAR();
    }
}
#undef LDS_BAR

constexpr int AT_K = 0, AT_V = 18432, AT_BIAS = 36864, AT_SCAN = AT_BIAS + 8192;
DI int crow(int r, int h) { return (r & 3) + 8 * (r >> 2) + 4 * h; }
DI s16x4 vtr(const LAS unsigned char* pp) { typedef short v4i16_t __attribute__((ext_vector_type(4))); return __builtin_bit_cast(s16x4, __builtin_amdgcn_ds_read_tr16_b64_v4i16((LAS v4i16_t*)pp)); }

template <bool SB>
DI void attn_unit(int b, int h, int qb, LAS unsigned char* lds, int dry = 0) {
    const KP p = kparams();
    const int tid = opaque_tid(), lane = tid & 63, wid = __builtin_amdgcn_readfirstlane(tid >> 6), r32 = lane & 31, hi = lane >> 5;
    bf16_t* proj = (bf16_t*)(p->ws + WS_PROJ);
    const int colQ = (SB ? 2048 : 3584) + h * 64, colK = colQ + 512, colV = colQ + 1024;
    const size_t rowbase = (size_t)b * SEQ;
    const int qmin = qb * 256 + wid * 32, qmax = qmin + 31, qrow = qmin + r32;
    const int NT = 4 * (qb + 1);
    LAS float* bias = (LAS float*)(lds + AT_BIAS);
    bf16x8 qr[4];
    { const bf16_t* qp = proj + (rowbase + qrow) * PP + colQ + hi * 8;
#pragma unroll
      for (int d0 = 0; d0 < 4; ++d0) qr[d0] = *(const bf16x8*)(qp + d0 * 16); }
    const int srow = tid >> 3, sch = tid & 7;
    const bf16_t* kg = proj + (rowbase + srow) * PP + colK + sch * 8;
    const bf16_t* vg = proj + (rowbase + srow) * PP + colV + sch * 8;
    const int soff = srow * 144 + sch * 16;
    const int jfirst = SB ? NT - 1 : 0;
    const u32x4 kreg0 = *(const u32x4*)(kg + (size_t)jfirst * 64 * PP), vreg0 = *(const u32x4*)(vg + (size_t)jfirst * 64 * PP);
    if (!SB) {
        const float* lf = (const float*)(p->ws + WS_LOGF) + ((size_t)b * 8 + h) * SEQ;
        LAS float* scanw = (LAS float*)(lds + AT_SCAN);
        const int n = 256 * (qb + 1);
        f32x4 v = (f32x4){0.f, 0.f, 0.f, 0.f};
        if (4 * tid < n) v = *(const f32x4*)(lf + 4 * tid);
        const float s1 = v[0], s2 = s1 + v[1], s3 = s2 + v[2], s4 = s3 + v[3];
        float sc = s4;
#pragma unroll
        for (int o = 1; o < 64; o <<= 1) { const float t = __shfl_up(sc, o); if (lane >= o) sc += t; }
        if (lane == 63) scanw[wid] = sc;
        __syncthreads();
        float off = sc - s4;
        for (int w = 0; w < wid; ++w) off += scanw[w];
        if (4 * tid < n) { f32x4 o; o[0] = -(off + s1) * LOG2E; o[1] = -(off + s2) * LOG2E; o[2] = -(off + s3) * LOG2E; o[3] = -(off + s4) * LOG2E; *(LAS f32x4*)(bias + 4 * tid) = o; }
    }
    *(LAS u32x4*)(lds + AT_K + soff) = kreg0; *(LAS u32x4*)(lds + AT_V + soff) = vreg0;
    __syncthreads();
    f32x16 y0, y1;
#pragma unroll
    for (int i = 0; i < 16; ++i) { y0[i] = 0.f; y1[i] = 0.f; }
    float mrun = -INFINITY, lrun = 0.f, carry = 0.f;
    LAS unsigned* xflag = (LAS unsigned*)(lds + AT_SCAN + 64);
    for (int it = 0; it < NT; ++it) {
        const int j = SB ? NT - 1 - it : it, buf = it & 1;
        const bool more = it + 1 < NT; const int jn = SB ? j - 1 : j + 1;
        u32x4 kreg, vreg;
        if (more) { kreg = *(const u32x4*)(kg + (size_t)jn * 64 * PP); vreg = *(const u32x4*)(vg + (size_t)jn * 64 * PP); }
        if (64 * j <= qmax && !(SB && __all(carry > 160.0f))) {
            const LAS unsigned char* Kb = lds + AT_K + buf * 9216; const LAS unsigned char* Vb = lds + AT_V + buf * 9216;
            f32x16 p0, p1;
            if (SB) {
#pragma unroll
                for (int i = 0; i < 16; ++i) { p0[i] = 0.f; p1[i] = 0.f; }
            } else {
                const LAS float* bp = bias + 64 * j + 4 * hi;
#pragma unroll
                for (int g = 0; g < 4; ++g) { const f32x4 t0 = *(const LAS f32x4*)(bp + 8 * g), t1 = *(const LAS f32x4*)(bp + 32 + 8 * g);
                    p0[4 * g] = t0[0]; p0[4 * g + 1] = t0[1]; p0[4 * g + 2] = t0[2]; p0[4 * g + 3] = t0[3];
                    p1[4 * g] = t1[0]; p1[4 * g + 1] = t1[1]; p1[4 * g + 2] = t1[2]; p1[4 * g + 3] = t1[3]; }
            }
#pragma unroll
            for (int d0 = 0; d0 < 4; ++d0) {
                const bf16x8 k0 = *(const LAS bf16x8*)(Kb + r32 * 144 + d0 * 32 + hi * 16), k1 = *(const LAS bf16x8*)(Kb + (32 + r32) * 144 + d0 * 32 + hi * 16);
                p0 = MFMA32(k0, qr[d0], p0); p1 = MFMA32(k1, qr[d0], p1);
            }
            const bool band = (64 * j + 63 >= qmin);
            if (SB) {
                float c0[16], c1[16];
#pragma unroll
                for (int i = 0; i < 16; ++i) {
                    const float z0 = p0[i], z1 = p1[i];
                    float a0 = fmaxf(z0, 0.f) + flog2(1.f + fexp2(-fabsf(z0))), a1 = fmaxf(z1, 0.f) + flog2(1.f + fexp2(-fabsf(z1)));
                    if (band) { const int kv = 64 * j + crow(i, hi); if (kv >= qrow) a0 = 0.f; if (kv + 32 >= qrow) a1 = 0.f; }
                    c0[i] = a0; c1[i] = a1;
                }
                float pr[8], tg[8];
#pragma unroll
                for (int g = 0; g < 4; ++g) { const float s0 = (c0[4 * g] + c0[4 * g + 1]) + (c0[4 * g + 2] + c0[4 * g + 3]), s1 = (c1[4 * g] + c1[4 * g + 1]) + (c1[4 * g + 2] + c1[4 * g + 3]);
                    tg[g] = __shfl_xor(s0, 32); tg[4 + g] = __shfl_xor(s1, 32); pr[g] = s0 + tg[g]; pr[4 + g] = s1 + tg[4 + g]; }
                float ps = 0.f;
#pragma unroll
                for (int g = 7; g >= 0; --g) {
                    const float sufex = carry + ps + (hi == 0 ? tg[g] : 0.f);
                    if (g >= 4) { const int gi = 4 * (g - 4);
                        const float C3 = sufex + c1[gi + 3], C2_ = C3 + c1[gi + 2], C1 = C2_ + c1[gi + 1], C0 = C1 + c1[gi];
                        p1[gi + 3] = fexp2(p1[gi + 3] - C3); p1[gi + 2] = fexp2(p1[gi + 2] - C2_); p1[gi + 1] = fexp2(p1[gi + 1] - C1); p1[gi] = fexp2(p1[gi] - C0);
                    } else { const int gi = 4 * g;
                        const float C3 = sufex + c0[gi + 3], C2_ = C3 + c0[gi + 2], C1 = C2_ + c0[gi + 1], C0 = C1 + c0[gi];
                        p0[gi + 3] = fexp2(p0[gi + 3] - C3); p0[gi + 2] = fexp2(p0[gi + 2] - C2_); p0[gi + 1] = fexp2(p0[gi + 1] - C1); p0[gi] = fexp2(p0[gi] - C0);
                    }
                    ps += pr[g];
                }
                carry += ps;
                if (band) {
#pragma unroll
                    for (int i = 0; i < 16; ++i) { const int kv = 64 * j + crow(i, hi); if (kv >= qrow) p0[i] = 0.f; if (kv + 32 >= qrow) p1[i] = 0.f; }
                }
            } else {
                if (band) {
#pragma unroll
                    for (int i = 0; i < 16; ++i) { const int kv = 64 * j + crow(i, hi); if (kv > qrow) p0[i] = -INFINITY; if (kv + 32 > qrow) p1[i] = -INFINITY; }
                }
                float rm = __builtin_fmaxf(p0[0], p1[0]), rm2 = __builtin_fmaxf(p0[1], p1[1]);
#pragma unroll
                for (int i = 2; i < 16; i += 2) { rm = __builtin_fmaxf(__builtin_fmaxf(rm, p0[i]), p1[i]); rm2 = __builtin_fmaxf(__builtin_fmaxf(rm2, p0[i + 1]), p1[i + 1]); }
                rm = __builtin_fmaxf(rm, rm2);
                rm = fmaxf(rm, __shfl_xor(rm, 32));
                if (__any(rm > mrun + 8.0f)) {
                    const float mnew = fmaxf(mrun, rm);
                    const float alpha = fexp2(mrun - mnew);
                    mrun = mnew; lrun *= alpha;
#pragma unroll
                    for (int i = 0; i < 16; ++i) { y0[i] *= alpha; y1[i] *= alpha; }
                }
                float rs = 0.f;
#pragma unroll
                for (int i = 0; i < 16; ++i) { p0[i] = fexp2(p0[i] - mrun); p1[i] = fexp2(p1[i] - mrun); rs += p0[i] + p1[i]; }
                lrun += rs;
            }
            const LAS unsigned char* vb = Vb + (4 * hi + ((lane & 15) >> 2)) * 144 + (16 * ((lane >> 4) & 1) + 4 * (lane & 3)) * 2;
#pragma unroll
            for (int pq = 0; pq < 2; ++pq)
#pragma unroll
                for (int ss = 0; ss < 2; ++ss) {
                    u32x4 pw;
                    if (pq == 0) { pw.x = cvtpk(p0[8 * ss], p0[8 * ss + 1]); pw.y = cvtpk(p0[8 * ss + 2], p0[8 * ss + 3]); pw.z = cvtpk(p0[8 * ss + 4], p0[8 * ss + 5]); pw.w = cvtpk(p0[8 * ss + 6], p0[8 * ss + 7]); }
                    else { pw.x = cvtpk(p1[8 * ss], p1[8 * ss + 1]); pw.y = cvtpk(p1[8 * ss + 2], p1[8 * ss + 3]); pw.z = cvtpk(p1[8 * ss + 4], p1[8 * ss + 5]); pw.w = cvtpk(p1[8 * ss + 6], p1[8 * ss + 7]); }
                    const bf16x8 xs = __builtin_bit_cast(bf16x8, pw);
                    const LAS unsigned char* vr = vb + (32 * pq + 16 * ss) * 144;
                    const s16x4 l0 = vtr(vr), h0 = vtr(vr + 8 * 144), l1 = vtr(vr + 64), h1 = vtr(vr + 8 * 144 + 64);
                    const bf16x8 pa0 = __builtin_shufflevector(l0, h0, 0, 1, 2, 3, 4, 5, 6, 7), pa1 = __builtin_shufflevector(l1, h1, 0, 1, 2, 3, 4, 5, 6, 7);
                    y0 = MFMA32(pa0, xs, y0); y1 = MFMA32(pa1, xs, y1);
                }
        }
        if (more) { *(LAS u32x4*)(lds + AT_K + (buf ^ 1) * 9216 + soff) = kreg; *(LAS u32x4*)(lds + AT_V + (buf ^ 1) * 9216 + soff) = vreg; }
        if (SB) {
            const bool sat = __all(carry > 160.0f);
            if (lane == 0) xflag[buf * 8 + wid] = sat ? 1u : 0u;
        }
        __syncthreads();
        if (SB) {
            unsigned allsat = 1u;
#pragma unroll
            for (int w = 0; w < 8; ++w) allsat &= xflag[buf * 8 + w];
            if (allsat) break;
        }
    }
    float inv = 1.f;
    if (!SB) { const float lt = lrun + __shfl_xor(lrun, 32); inv = 1.0f / lt; }
    bf16_t* op = proj + (rowbase + qrow) * PP + colQ + 4 * hi;
#pragma unroll
    for (int g = 0; g < 4; ++g) {
        u32x2 w0, w1;
        w0.x = cvtpk(y0[4 * g] * inv, y0[4 * g + 1] * inv); w0.y = cvtpk(y0[4 * g + 2] * inv, y0[4 * g + 3] * inv);
        w1.x = cvtpk(y1[4 * g] * inv, y1[4 * g + 1] * inv); w1.y = cvtpk(y1[4 * g + 2] * inv, y1[4 * g + 3] * inv);
        if (!dry) { *(u32x2*)(op + 8 * g) = w0; *(u32x2*)(op + 32 + 8 * g) = w1; }
    }
}


#define XB_TMO      128
#define XB_XCNT(j)  (256  + 64 * (j))
#define XB_XSUB(j)  (1280 + 64 * (j))
#define XB_XGEN(j)  (2304 + 64 * (j))
#define XB_TOP      3328
#define XB_TOPGEN   3392
#define XCD_BAR_WORDS 3456
#define XL_SUB(j)   (3456 + 64 * (j))
#define XL_GEN(j)   (4480 + 64 * (j))
#define BAR_WORDS_ALL 5504
#define XB_SPIN_CAP (1u << 18)
DI unsigned xb_ld(unsigned* p)              { return __hip_atomic_load(p, __ATOMIC_RELAXED, __HIP_MEMORY_SCOPE_AGENT); }
DI unsigned xb_add(unsigned* p, unsigned v) { return __hip_atomic_fetch_add(p, v, __ATOMIC_RELAXED, __HIP_MEMORY_SCOPE_AGENT); }
DI unsigned xb_xcc_id() { return (unsigned)__builtin_amdgcn_s_getreg((3 << 11) | 20) & 0xFu; }
#define XB_SPIN(cond, bar) do { unsigned _sp = 0; while (cond) { __builtin_amdgcn_s_sleep(1); \
    if ((++_sp & 255u) == 0u) { if (xb_ld(&(bar)[XB_TMO])) break; if (_sp > XB_SPIN_CAP) { atomicAdd(&(bar)[XB_TMO], 1u); break; } } } } while (0)
struct XcdBarrier { unsigned* bar; unsigned x; volatile LAS unsigned* st; };
DI XcdBarrier xcd_barrier_post(unsigned* bar, volatile LAS unsigned* st) {
    XcdBarrier b; b.bar = bar; b.x = xb_xcc_id(); b.st = st;
    if (threadIdx.x == 0) st[2] = xb_add(&bar[XB_XCNT(b.x)], 1u);
    return b;
}
DI void xcd_barrier_complete(unsigned* bar, unsigned x, unsigned& nloc, unsigned& nx) {
    const unsigned G = gridDim.x * gridDim.y * gridDim.z;
    unsigned sum, cnt, mine, sp = 0u;
    for (;;) {
        sum = 0u; cnt = 0u; mine = 0u;
#pragma unroll
        for (unsigned j = 0; j < 16; ++j) { const unsigned c = xb_ld(&bar[XB_XCNT(j)]); sum += c; cnt += (c > 0u) ? 1u : 0u; mine = (j == x) ? c : mine; }
        if (sum == G) break;
        __builtin_amdgcn_s_sleep(1);
        if ((++sp & 255u) == 0u) { if (xb_ld(&bar[XB_TMO])) break; if (sp > XB_SPIN_CAP) { atomicAdd(&bar[XB_TMO], 1u); break; } }
    }
    nloc = mine > 0u ? mine : 1u; nx = cnt > 0u ? cnt : 1u;
}
DI void xcd_local_barrier(unsigned* bar, unsigned x) {
    asm volatile("s_waitcnt vmcnt(0)" ::: "memory");
    __syncthreads();
    if (threadIdx.x == 0) {
        __builtin_amdgcn_s_waitcnt(0);
        const unsigned old = xb_add(&bar[XL_SUB(x)], 1u);
        const unsigned gen = old / 32u;
        if (old + 1u == (gen + 1u) * 32u) {
            __builtin_amdgcn_fence(__ATOMIC_RELEASE, "agent");
            asm volatile("s_waitcnt vmcnt(0)" ::: "memory");
            xb_add(&bar[XL_GEN(x)], 1u);
        } else XB_SPIN(xb_ld(&bar[XL_GEN(x)]) == gen, bar);
        __builtin_amdgcn_fence(__ATOMIC_ACQUIRE, "agent");
        asm volatile("s_waitcnt vmcnt(0)" ::: "memory");
    }
    __syncthreads();
}
DI void xcd_barrier(const XcdBarrier& b) {
    asm volatile("s_waitcnt vmcnt(0)" ::: "memory");
    __syncthreads();
    if (threadIdx.x == 0) {
        unsigned* bar = b.bar;
        __builtin_amdgcn_s_waitcnt(0);
        unsigned nloc = b.st[0], nx = b.st[1];
        if (nloc == 0u) { xcd_barrier_complete(bar, b.x, nloc, nx); b.st[0] = nloc; b.st[1] = nx; }
        const unsigned old = xb_add(&bar[XB_XSUB(b.x)], 1u);
        const unsigned gen = old / nloc;
        if (old + 1u == (gen + 1u) * nloc) {
            __builtin_amdgcn_fence(__ATOMIC_RELEASE, "agent");
            asm volatile("s_waitcnt vmcnt(0)" ::: "memory");
            const unsigned og = xb_add(&bar[XB_TOP], 1u);
            const unsigned tg = og / nx;
            if (og + 1u == (tg + 1u) * nx) xb_add(&bar[XB_TOPGEN], 1u);
            else XB_SPIN(xb_ld(&bar[XB_TOPGEN]) == tg, bar);
            __builtin_amdgcn_fence(__ATOMIC_ACQUIRE, "agent");
            xb_add(&bar[XB_XGEN(b.x)], 1u);
            asm volatile("s_waitcnt vmcnt(0)" ::: "memory");
        } else {
            XB_SPIN(xb_ld(&bar[XB_XGEN(b.x)]) == gen, bar);
            __builtin_amdgcn_fence(__ATOMIC_ACQUIRE, "agent");
            asm volatile("s_waitcnt vmcnt(0)" ::: "memory");
        }
    }
    __syncthreads();
}

template <int KIND>
DI void run_gemm(LAS unsigned char* lds, int l, int ffn, int c, int sub, int dry = 0, int xcc = -1) {
    const KP p = kparams();
    unsigned char* ws = p->ws;
    pg8::EpiCtx E; E.hid = (bf16_t*)(ws + WS_HID); E.proj = (bf16_t*)(ws + WS_PROJ); E.hbuf = (KIND == 1 && l == 1 && ffn == 1) ? (bf16_t*)(ws + WS_DLAST) : (bf16_t*)p->out;
    E.mod = (const float*)(ws + WS_MOD) + (size_t)l * NB * NADA; E.merge_b = p->in[16] + (size_t)l * 3072;
    E.gscr = (bf16_t*)(ws + WS_GSCR) + (size_t)blockIdx.x * 65536; E.dry = dry;
    pg8::Sched S; S.kind = KIND; S.G = (xcc >= 0) ? 32 : (int)gridDim.x; S.c = c; S.sub = sub; S.A1 = nullptr; S.B1 = nullptr; S.nM = (xcc >= 0) ? 16 : 128; S.pmoff = (xcc >= 0) ? 16 * xcc : 0;
    if (KIND == 0) { S.A0 = (const char*)p->out; S.B0 = (const char*)(ws + (ffn ? WS_WUP2 : WS_WUP1)); }
    else if (KIND == 1) { S.A0 = (const char*)(ws + WS_HID); S.B0 = (const char*)(ws + (ffn ? WS_WDN2 : WS_WDN1)); }
    else if (KIND == 2) { S.A0 = (const char*)p->out; S.B0 = (const char*)(ws + WS_WIN); }
    else if (KIND == 3) { S.A0 = (const char*)p->out; S.B0 = (const char*)(ws + WS_WG); }
    else if (KIND == 5) { S.A0 = (const char*)(ws + WS_PROJ); S.B0 = (const char*)(ws + WS_WM); }
    else { S.A0 = (const char*)(ws + WS_PROJ); S.B0 = (const char*)(ws + WS_WO); }
    pg8::gemm_phase(lds, S, E);
}

__global__ void __launch_bounds__(NTHR, 2) fwd_megakernel(Params p_unused) {
    extern __shared__ __attribute__((aligned(16))) unsigned char lds_raw[];
    LAS unsigned char* lds = (LAS unsigned char*)lds_raw;
    cg::grid_group grid = cg::this_grid();
    const int G = gridDim.x, bx = blockIdx.x;
    { const KP p = kparams(); unsigned* bw = (unsigned*)p->ws;
      if (bx == 0) for (int i = threadIdx.x; i < BAR_WORDS_ALL; i += NTHR) __hip_atomic_store(bw + i, 0u, __ATOMIC_RELAXED, __HIP_MEMORY_SCOPE_AGENT);
      if (threadIdx.x < 4) ((volatile LAS unsigned*)(lds + 131072))[threadIdx.x] = 0u; }
    int vb = bx, xl = 0, xcc = -1, rk = 0;
#define GW_ARGS (int)(vb * NWAVES + __builtin_amdgcn_readfirstlane(opaque_tid() >> 6)), G * NWAVES

#ifndef NFWD
#define NFWD 1
#endif
    XcdBarrier xbar; xbar.bar = nullptr; xbar.x = 0; xbar.st = nullptr;
    for (int fwd = 0; fwd < NFWD; ++fwd) {
    if (RUN(0)) for (int u = vb; u < 160; u += G) ada_unit(u, lds);
    if (RUN(1)) convert_weights(0, lds, GW_ARGS);
    if (fwd == 0) { grid.sync(); xbar = xcd_barrier_post((unsigned*)kparams()->ws, (volatile LAS unsigned*)(lds + 131072)); }
    else { XcdBarrier b_ = xbar; b_.bar = (unsigned*)kparams()->ws; xcd_barrier(b_); }
#define SEAM_G() do { XcdBarrier b_ = xbar; b_.bar = (unsigned*)kparams()->ws; xcd_barrier(b_); } while (0)
#define SEAM_L() do { if (xl) xcd_local_barrier((unsigned*)kparams()->ws, (unsigned)xcc); else SEAM_G(); } while (0)
#define LOC (xl ? xcc : -1)

    for (int l = 0; l < 2; ++l) {
        if (RUN(1)) if (l == 1) convert_weights(1, lds, GW_ARGS);
        if (RUN(2)) { if (l == 0) norm_phase(l, 1, 0, lds, GW_ARGS); else norm_phase(l, 0, 0, lds, GW_ARGS, 2, 0); }
        SEAM_G();
        if (l == 0 && fwd == 0 && G == 256) {
            unsigned* bw = (unsigned*)kparams()->ws; bool ok = true;
#pragma unroll
            for (int j = 0; j < 16; ++j) { const unsigned cnt = xb_ld(&bw[XB_XCNT(j)]); ok = ok && (cnt == (j < 8 ? 32u : 0u)); }
            const unsigned r_ = ((volatile LAS unsigned*)(lds + 131072))[2];
            if (ok && r_ < 32u && xbar.x < 8u) { xl = 1; xcc = (int)xbar.x; rk = (int)r_; vb = xcc * 32 + rk; }
        }
        const int gc = xl ? rk : bx;
        if (RUN(3)) run_gemm<0>(lds, l, 0, gc, 0, 0, LOC);
        SEAM_L();
        if (RUN(4)) run_gemm<1>(lds, l, 0, gc, 0, 0, LOC);
        SEAM_L();
        if (RUN(5)) norm_phase(l, 2, 1, lds, GW_ARGS, 0, l);
        SEAM_L();
        if (RUN(6)) run_gemm<2>(lds, l, 0, gc, 0, 0, LOC);
        SEAM_L();
        for (int u = vb; u < 256 + 2048; u += G) {
            if (u < 256) { if (RUN(7)) rg_unit(l, u >> 4, u & 15, lds); }
            else { const int a = u - 256, lv = a >> 8, cc = a & 255, qb = 7 - lv, bh = cc >> 1;
                const int ty = (((0x99 >> qb) ^ cc) & 1) ? 0 : 1;
                if (ty == 0) { if (RUN(8)) attn_unit<true>(bh >> 3, bh & 7, qb, lds); } else { if (RUN(9)) attn_unit<false>(bh >> 3, bh & 7, qb, lds); } }
        }
        SEAM_L();
        if (RUN(10)) {
            if (xl) { for (int L = rk; L < 64; L += 32) for (int j = 0; j < 3; ++j) { run_gemm<3>(lds, l, 0, L, j, 0, xcc); run_gemm<5>(lds, l, 0, L, j, 0, xcc); } }
            else { for (int L = bx; L < 512; L += G) for (int j = 0; j < 3; ++j) { run_gemm<3>(lds, l, 0, L, j); run_gemm<5>(lds, l, 0, L, j); } }
        }
        SEAM_L();
        if (RUN(11)) run_gemm<4>(lds, l, 0, gc, 1, 0, LOC);
        SEAM_L();
        if (RUN(12)) norm_phase(l, 0, 2, lds, GW_ARGS, 1, l);
        SEAM_L();
        if (RUN(13)) run_gemm<0>(lds, l, 1, gc, 0, 0, LOC);
        SEAM_L();
        if (RUN(14)) run_gemm<1>(lds, l, 1, gc, 2, 0, LOC);
        if (l == 0) SEAM_G(); else SEAM_L();
    }
    if (RUN(15)) norm_phase(0, 3, 0, lds, GW_ARGS, 2, 1);
    if (fwd + 1 < NFWD) SEAM_G();
    }
}

extern "C" void kernel_launch(void* const* d_in, const int* in_sizes, int n_in, void* d_out, int out_size, void* d_ws, size_t ws_size, hipStream_t stream) {
    static int grid = 0;
    if (grid == 0) {
        if (n_in != 30 || out_size != M * DM || ws_size < WS_END) { fprintf(stderr, "kernel_launch: unexpected shapes (n_in %d out %d ws %zu)\n", n_in, out_size, ws_size); grid = -1; return; }
        int dev = 0, cus = 0, per_cu = 0;
        (void)hipGetDevice(&dev);
        (void)hipDeviceGetAttribute(&cus, hipDeviceAttributeMultiprocessorCount, dev);
        if (hipFuncSetAttribute((const void*)fwd_megakernel, hipFuncAttributeMaxDynamicSharedMemorySize, LDS_BYTES) != hipSuccess) { fprintf(stderr, "kernel_launch: hipFuncSetAttribute failed\n"); grid = -1; return; }
        if (hipOccupancyMaxActiveBlocksPerMultiprocessor(&per_cu, (const void*)fwd_megakernel, NTHR, LDS_BYTES) != hipSuccess || per_cu < 1) per_cu = 1;
        (void)hipGetLastError();
        grid = cus >= 256 ? 256 : cus;
        (void)per_cu;
    }
    if (grid < 0) return;
    Params p{};
    for (int i = 0; i < 30; ++i) p.in[i] = (const float*)d_in[i];
    p.out = (float*)d_out; p.ws = (unsigned char*)d_ws;
    void* args[] = {&p};
    hipError_t e = hipLaunchCooperativeKernel((const void*)fwd_megakernel, dim3(grid), dim3(NTHR), args, LDS_BYTES, stream);
    if (e != hipSuccess) fprintf(stderr, "cooperative launch failed: %s (grid %d)\n", hipGetErrorString(e), grid);
}
```

```cpp
#include <hip/hip_runtime.h>
#include <hip/hip_cooperative_groups.h>
#include <cstdio>
#include <cstdint>
namespace cg = cooperative_groups;
#ifndef SKIPM
#define SKIPM 0
#endif
#define RUN(bit) (fwd != 0 || !((SKIPM) >> (bit) & 1))
#ifndef REPM
#define REPM 0
#endif
#define REP(bit) (((REPM) >> (bit)) & 1)

#define LAS __attribute__((address_space(3)))
#define DI __device__ __forceinline__
typedef unsigned short bf16_t;
typedef short bf16x8 __attribute__((ext_vector_type(8)));
typedef short s16x4 __attribute__((ext_vector_type(4)));
typedef float f32x4 __attribute__((ext_vector_type(4)));
typedef float f32x16 __attribute__((ext_vector_type(16)));
typedef unsigned u32x4 __attribute__((ext_vector_type(4)));
typedef unsigned u32x2 __attribute__((ext_vector_type(2)));

constexpr int NB = 16, SEQ = 2048, DM = 1024, DFF = 2816, M = NB * SEQ, PP = 5120  , NADA = 9216;
constexpr int NWAVES = 8, NTHR = 512;
constexpr float EPS = 1e-6f;
constexpr float LOG2E = 1.4426950408889634f;
constexpr float C2 = 0.125f * LOG2E;
constexpr size_t MiB = 1u << 20;
constexpr size_t WS_MOD = 1 * MiB;
constexpr size_t WS_FM = WS_MOD + (size_t)2 * NB * NADA * 4;
constexpr size_t WS_LOGF = 3 * MiB;
constexpr size_t WS_GSCR = 4 * MiB;
constexpr size_t WS_WUP1 = 36 * MiB;
constexpr size_t WS_WDN1 = 47 * MiB;
constexpr size_t WS_WUP2 = 53 * MiB;
constexpr size_t WS_WDN2 = 64 * MiB;
constexpr size_t WS_WIN = 70 * MiB;
constexpr size_t WS_WG = 80 * MiB;
constexpr size_t WS_WM = 86 * MiB;
constexpr size_t WS_WO = 90 * MiB;
constexpr size_t WS_XB = 92 * MiB;
constexpr size_t WS_DLAST = 332 * MiB;
constexpr size_t WS_PROJ = 156 * MiB;
constexpr size_t WS_HID = 156 * MiB;
constexpr size_t WS_END = 476 * MiB;
constexpr int LDS_BYTES = 147456;
constexpr int LDS_CTL = LDS_BYTES - 64;

struct Params { const float* in[30]; float* out; unsigned char* ws; };
typedef const __attribute__((address_space(4))) Params* KP;
__device__ __forceinline__ KP kparams() { KP q = (KP)__builtin_amdgcn_kernarg_segment_ptr(); asm volatile("" : "+s"(q)); return q; }

DI unsigned cvtpk(float lo, float hi) { typedef float f2 __attribute__((ext_vector_type(2))); typedef __bf16 b2 __attribute__((ext_vector_type(2))); f2 v = {lo, hi}; b2 b = __builtin_convertvector(v, b2); return __builtin_bit_cast(unsigned, b); }
DI float bf_lo(unsigned w) { return __uint_as_float(w << 16); }
DI float bf_hi(unsigned w) { return __uint_as_float(w & 0xffff0000u); }
DI float bf1(bf16_t v) { return __uint_as_float(((unsigned)v) << 16); }
DI bf16_t f2bf(float f) { return (bf16_t)(cvtpk(f, 0.f) & 0xffffu); }
DI float fexp2(float x) { return __builtin_amdgcn_exp2f(x); }
DI float flog2(float x) { return __builtin_amdgcn_logf(x); }
DI float frcp(float x) { return __builtin_amdgcn_rcpf(x); }
DI float sigmoidf(float v) { return frcp(1.f + fexp2(-v * LOG2E)); }
DI int opaque_tid() { int t = threadIdx.x; asm volatile("" : "+v"(t)); return t; }
DI float wave_sum(float v) {
#pragma unroll
    for (int o = 1; o < 64; o <<= 1) v += __shfl_xor(v, o);
    return v;
}
#define MFMA32(a, b, c) __builtin_amdgcn_mfma_f32_32x32x16_bf16((a), (b), (c), 0, 0, 0)
#define MFMA16(a, b, c) __builtin_amdgcn_mfma_f32_16x16x32_bf16((a), (b), (c), 0, 0, 0)

namespace pg8 {
constexpr int BM = 256, BK = 64, HALF = 128, HTB = HALF * BK * 2, STAGE_BYTES = 8 * HTB, NXCD = 8, WGM = 8;
DI int lds_byte(int r, int c) { const int st = (r >> 4) * 2 + (c >> 5), rr = r & 15, cc = c & 31, ob = rr * 64 + cc * 2; return st * 1024 + (ob ^ (((ob >> 9) & 1) << 5)); }
DI void stage_rc(int b, int& R, int& C) { const int st = b / 1024, sb = b % 1024, swz = sb ^ (((sb >> 9) & 1) << 5); R = (st >> 1) * 16 + swz / 64; C = (st & 1) * 32 + (swz % 64) / 2; }
DI int perm32(int rho) { const int n = rho >> 4, i = rho & 15; return 8 * (i >> 2) + 4 * n + (i & 3); }

enum { MODE_SWIGLU = 0, MODE_RESID = 1, MODE_PROJ = 2, MODE_GATE = 3, MODE_BRANCH = 4 };
struct Unit { const char* A; const char* B; unsigned lda, ldb; int nt, mode, pm, pn, aux; };
struct EpiCtx { bf16_t* hid; bf16_t* proj; bf16_t* hbuf; const float* mod; const float* merge_b; bf16_t* gscr; int dry; };

DI void tile_of(int L, int nM, int nN, int& pm, int& pn) {
    const int nwg = nM * nN; int wgid = L;
    { const int q = nwg / NXCD, r = nwg % NXCD, xcd = wgid % NXCD, off = wgid / NXCD; wgid = (xcd < r ? xcd * (q + 1) : r * (q + 1) + (xcd - r) * q) + off; }
    const int nig = WGM * nN, gid = wgid / nig, fm = gid * WGM, gsz = (nM - fm) < WGM ? (nM - fm) : WGM;
    pm = fm + ((wgid % nig) % gsz); pn = (wgid % nig) / gsz;
}

struct Sched {
    int kind, G, c, sub;
    const char *A0, *B0, *A1, *B1;
    DI bool next(int i, Unit& u) const {
        if (kind == 0) { const long L = (long)i * G + c; if (L >= 128 * 22) return false; tile_of((int)L, 128, 22, u.pm, u.pn);
            u.lda = 2048u; u.ldb = 2048u; u.A = A0 + (size_t)u.pm * 256 * 2048; u.B = B0 + (size_t)u.pn * 256 * 2048; u.nt = 16; u.mode = MODE_SWIGLU; u.aux = 0; return true; }
        if (kind == 1) { const long L = (long)i * G + c; if (L >= 128 * 4) return false; tile_of((int)L, 128, 4, u.pm, u.pn);
            u.lda = 5632u; u.ldb = 5632u; u.A = A0 + (size_t)u.pm * 256 * 5632; u.B = B0 + (size_t)u.pn * 256 * 5632; u.nt = 44; u.mode = MODE_RESID; u.aux = sub; return true; }
        if (kind == 2) { const long L = (long)i * G + c; if (L >= 128 * 20) return false; tile_of((int)L, 128, 20, u.pm, u.pn);
            u.lda = 2048u; u.ldb = 2048u; u.A = A0 + (size_t)u.pm * 256 * 2048; u.B = B0 + (size_t)u.pn * 256 * 2048; u.nt = 16; u.mode = MODE_PROJ; u.aux = 0; return true; }
        if (kind == 3) { if (i != 0) return false; tile_of(c, 128, 4, u.pm, u.pn); const int j = sub; u.aux = j;
            u.lda = 2048u; u.ldb = 2048u; u.A = A0 + (size_t)u.pm * 256 * 2048; u.B = B0 + (size_t)(j * 1024 + u.pn * 256) * 2048; u.nt = 16; u.mode = MODE_GATE; return true; }
        if (kind == 5) { if (i != 0) return false; tile_of(c, 128, 4, u.pm, u.pn); const int j = sub; u.aux = j;
            const int acol = (j == 0) ? 1024 : (j == 1 ? 2048 : 3584), kcol = (j == 0) ? 0 : (j == 1 ? 1024 : 1536);
            u.lda = PP * 2u; u.ldb = 4096u; u.A = A0 + (size_t)u.pm * 256 * (PP * 2) + acol * 2; u.B = B0 + (size_t)u.pn * 256 * 4096 + kcol * 2; u.nt = (j == 0) ? 16 : 8; u.mode = MODE_BRANCH; return true; }
        { const long L = (long)i * G + c; if (L >= 128 * 4) return false; tile_of((int)L, 128, 4, u.pm, u.pn);
            u.lda = PP * 2u; u.ldb = 2048u; u.A = A0 + (size_t)u.pm * 256 * (PP * 2); u.B = B0 + (size_t)u.pn * 256 * 2048; u.nt = 16; u.mode = MODE_RESID; u.aux = 1; return true; }
    }
};

DI void epilogue(const f32x4 (&acc)[2][2][4][2], const Unit& u, const EpiCtx& E, int tid, int wr, int wc, int fr, int fq) {
    const int row0 = u.pm * BM + wr * 64 + fr, colw = wc * 32 + 8 * fq;
    if (u.mode == MODE_SWIGLU) {
#pragma unroll
        for (int ai = 0; ai < 2; ++ai)
#pragma unroll
            for (int m = 0; m < 4; ++m) {
                bf16_t* rowp = E.hid + (size_t)(row0 + ai * HALF + m * 16) * DFF + u.pn * 128 + colw;
                float o[8];
#pragma unroll
                for (int n = 0; n < 2; ++n)
#pragma unroll
                    for (int e = 0; e < 4; ++e) { const float a = acc[ai][0][m][n][e], g = acc[ai][1][m][n][e]; o[4 * n + e] = a * sigmoidf(a) * g; }
                u32x4 w; w.x = cvtpk(o[0], o[1]); w.y = cvtpk(o[2], o[3]); w.z = cvtpk(o[4], o[5]); w.w = cvtpk(o[6], o[7]);
                *(u32x4*)rowp = w;
            }
    } else if (u.mode == MODE_RESID) {
#pragma unroll
        for (int ai = 0; ai < 2; ++ai)
#pragma unroll
            for (int m = 0; m < 4; ++m) {
                bf16_t* rowp = E.hbuf + (size_t)(row0 + ai * HALF + m * 16) * DM + u.pn * BM + colw;
#pragma unroll
                for (int bj = 0; bj < 2; ++bj) { const f32x4 v0 = acc[ai][bj][m][0], v1 = acc[ai][bj][m][1];
                    u32x4 w; w.x = cvtpk(v0[0], v0[1]); w.y = cvtpk(v0[2], v0[3]); w.z = cvtpk(v1[0], v1[1]); w.w = cvtpk(v1[2], v1[3]);
                    *(u32x4*)(rowp + bj * HALF) = w; }
            }
    } else if (u.mode == MODE_PROJ) {
        const float sc = (u.pn == 8 || u.pn == 9 || u.pn == 14 || u.pn == 15) ? C2 : 1.0f;
#pragma unroll
        for (int ai = 0; ai < 2; ++ai)
#pragma unroll
            for (int m = 0; m < 4; ++m) {
                bf16_t* rowp = E.proj + (size_t)(row0 + ai * HALF + m * 16) * PP + u.pn * BM + colw;
#pragma unroll
                for (int bj = 0; bj < 2; ++bj) { const f32x4 v0 = acc[ai][bj][m][0] * sc, v1 = acc[ai][bj][m][1] * sc;
                    u32x4 w; w.x = cvtpk(v0[0], v0[1]); w.y = cvtpk(v0[2], v0[3]); w.z = cvtpk(v1[0], v1[1]); w.w = cvtpk(v1[2], v1[3]);
                    *(u32x4*)(rowp + bj * HALF) = w; }
            }
    } else if (u.mode == MODE_GATE) {
        const float* bp = E.merge_b + u.aux * 1024 + u.pn * BM + colw;
        f32x4 bv[2][2];
#pragma unroll
        for (int bj = 0; bj < 2; ++bj)
#pragma unroll
            for (int n = 0; n < 2; ++n) bv[bj][n] = *(const f32x4*)(bp + bj * HALF + 4 * n);
#pragma unroll
        for (int ai = 0; ai < 2; ++ai)
#pragma unroll
            for (int m = 0; m < 4; ++m)
#pragma unroll
                for (int bj = 0; bj < 2; ++bj) { float o[8];
#pragma unroll
                    for (int n = 0; n < 2; ++n)
#pragma unroll
                        for (int e = 0; e < 4; ++e) o[4 * n + e] = sigmoidf(acc[ai][bj][m][n][e] + bv[bj][n][e]);
                    u32x4 w; w.x = cvtpk(o[0], o[1]); w.y = cvtpk(o[2], o[3]); w.z = cvtpk(o[4], o[5]); w.w = cvtpk(o[6], o[7]);
                    *(u32x4*)(E.gscr + ((size_t)(((ai * 4 + m) * 2 + bj) * NTHR) + tid) * 8) = w; }
    } else {
        const float dm = (E.dry && u.aux != 0) ? 0.0f : 1.0f;
#pragma unroll
        for (int ai = 0; ai < 2; ++ai)
#pragma unroll
            for (int m = 0; m < 4; ++m) {
                bf16_t* rowp = E.proj + (size_t)(row0 + ai * HALF + m * 16) * PP + u.pn * BM + colw;
#pragma unroll
                for (int bj = 0; bj < 2; ++bj) {
                    const u32x4 g = *(const u32x4*)(E.gscr + ((size_t)(((ai * 4 + m) * 2 + bj) * NTHR) + tid) * 8);
                    float o[8];
                    o[0] = dm * bf_lo(g.x) * acc[ai][bj][m][0][0]; o[1] = dm * bf_hi(g.x) * acc[ai][bj][m][0][1]; o[2] = dm * bf_lo(g.y) * acc[ai][bj][m][0][2]; o[3] = dm * bf_hi(g.y) * acc[ai][bj][m][0][3];
                    o[4] = dm * bf_lo(g.z) * acc[ai][bj][m][1][0]; o[5] = dm * bf_hi(g.z) * acc[ai][bj][m][1][1]; o[6] = dm * bf_lo(g.w) * acc[ai][bj][m][1][2]; o[7] = dm * bf_hi(g.w) * acc[ai][bj][m][1][3];
                    if (u.aux != 0) { const u32x4 q = *(const u32x4*)(rowp + bj * HALF);
                        o[0] += bf_lo(q.x); o[1] += bf_hi(q.x); o[2] += bf_lo(q.y); o[3] += bf_hi(q.y); o[4] += bf_lo(q.z); o[5] += bf_hi(q.z); o[6] += bf_lo(q.w); o[7] += bf_hi(q.w); }
                    u32x4 w; w.x = cvtpk(o[0], o[1]); w.y = cvtpk(o[2], o[3]); w.z = cvtpk(o[4], o[5]); w.w = cvtpk(o[6], o[7]);
                    *(u32x4*)(rowp + bj * HALF) = w; }
                asm volatile("" ::: "memory");
            }
    }
}

DI void gemm_phase(LAS unsigned char* lds, const Sched& S, const EpiCtx& E) {
    const int tid = opaque_tid(), wid = __builtin_amdgcn_readfirstlane(tid >> 6), lane = tid & 63, wr = wid >> 2, wc = wid & 3, fr = lane & 15, fq = lane >> 4;
    int R0, C0; stage_rc(tid * 16, R0, C0);
    const int Rb0 = (R0 & ~31) + perm32(R0 & 31);
    const size_t kstep = (size_t)(BK * 2);
    const unsigned ldsw = (unsigned)wid * 1024u;
    const int aoff = lds_byte(wr * 64 + fr, fq * 8), boff = lds_byte(wc * 32 + fr, fq * 8);
#define PG8_SA(b, h) (((b) * 2 + (h)) * HTB)
#define PG8_SB(b, h) ((4 + (b) * 2 + (h)) * HTB)
#define PG8_STAGE(bufoff, gbase, v0, ld) do { \
        __builtin_amdgcn_global_load_lds((const unsigned*)((const char*)(gbase) + (v0)), (LAS unsigned*)(lds + (bufoff) + ldsw), 16, 0, 0); \
        __builtin_amdgcn_global_load_lds((const unsigned*)((const char*)(gbase) + (size_t)(ld) * 64 + (v0)), (LAS unsigned*)(lds + (bufoff) + ldsw + 8192), 16, 0, 0); } while (0)
#define PG8_LDA(dst, b, h) do { _Pragma("unroll") for (int m = 0; m < 4; ++m) _Pragma("unroll") for (int k = 0; k < 2; ++k) dst[m][k] = *(const LAS bf16x8*)(lds + PG8_SA(b, h) + aoff + m * 2048 + k * 1024); } while (0)
#define PG8_LDB(dst, b, h) do { _Pragma("unroll") for (int n = 0; n < 2; ++n) _Pragma("unroll") for (int k = 0; k < 2; ++k) dst[n][k] = *(const LAS bf16x8*)(lds + PG8_SB(b, h) + boff + n * 2048 + k * 1024); } while (0)
#define PG8_MMA(ai, bj, At, Bt) do { __builtin_amdgcn_s_setprio(1); _Pragma("unroll") for (int m = 0; m < 4; ++m) _Pragma("unroll") for (int n = 0; n < 2; ++n) _Pragma("unroll") for (int k = 0; k < 2; ++k) \
        acc[ai][bj][m][n] = __builtin_amdgcn_mfma_f32_16x16x32_bf16(Bt[n][k], At[m][k], acc[ai][bj][m][n], 0, 0, 0); __builtin_amdgcn_s_setprio(0); } while (0)
#define PG8_WAIT_V(n) asm volatile("s_waitcnt vmcnt(" #n ")" ::: "memory")
#define PG8_WAIT_L(n) asm volatile("s_waitcnt lgkmcnt(" #n ")" ::: "memory")
#define PG8_BAR __builtin_amdgcn_s_barrier()
#define PG8_SCHED __builtin_amdgcn_sched_barrier(0)
    Unit cur, nxt; int ui = 0;
    if (!S.next(0, cur)) return;
    f32x4 acc[2][2][4][2];
#pragma unroll
    for (int a = 0; a < 2; ++a)
#pragma unroll
        for (int b = 0; b < 2; ++b)
#pragma unroll
            for (int m = 0; m < 4; ++m)
#pragma unroll
                for (int n = 0; n < 2; ++n) acc[a][b][m][n] = (f32x4){0.f, 0.f, 0.f, 0.f};
    bf16x8 At[4][2], B0[2][2], B1[2][2];
    const char* cA = cur.A; const char* cB = cur.B;
    unsigned vA0 = (unsigned)R0 * cur.lda + (unsigned)C0 * 2u, vB0 = (unsigned)Rb0 * cur.ldb + (unsigned)C0 * 2u;
    unsigned lA = cur.lda, lB = cur.ldb;
    size_t hA = (size_t)HALF * cur.lda, hB = (size_t)HALF * cur.ldb;
    PG8_STAGE(PG8_SB(0, 0), cB, vB0, lB); PG8_STAGE(PG8_SB(0, 1), cB + hB, vB0, lB); PG8_STAGE(PG8_SA(0, 0), cA, vA0, lA); PG8_STAGE(PG8_SA(0, 1), cA + hA, vA0, lA);
    if (wr == 1) PG8_BAR;
    PG8_WAIT_V(2); PG8_BAR;
    PG8_STAGE(PG8_SB(1, 0), cB + kstep, vB0, lB); PG8_STAGE(PG8_SA(1, 0), cA + kstep, vA0, lA); PG8_STAGE(PG8_SB(1, 1), cB + hB + kstep, vB0, lB);
    PG8_WAIT_V(6); PG8_BAR;
    for (;;) {
        const bool has_next = S.next(ui + 1, nxt);
        const char* nA = has_next ? nxt.A : cA; const char* nB = has_next ? nxt.B : cB;
        const unsigned nlda = has_next ? nxt.lda : cur.lda, nldb = has_next ? nxt.ldb : cur.ldb;
        const unsigned nvA0 = (unsigned)R0 * nlda + (unsigned)C0 * 2u, nvB0 = (unsigned)Rb0 * nldb + (unsigned)C0 * 2u;
        const size_t nhA = (size_t)HALF * nlda, nhB = (size_t)HALF * nldb;
        const int nt = cur.nt;
        for (int t = 0; t < nt; t += 2) {
            const bool last = (t == nt - 2);
            const char* a1 = cA + (size_t)(t + 1) * kstep;
            const char* a2 = last ? nA : cA + (size_t)(t + 2) * kstep; const char* b2 = last ? nB : cB + (size_t)(t + 2) * kstep;
            const char* a3 = a2 + kstep; const char* b3 = b2 + kstep;
            const unsigned xA0 = last ? nvA0 : vA0, xB0 = last ? nvB0 : vB0, xlA = last ? nlda : lA, xlB = last ? nldb : lB;
            const size_t xhA = last ? nhA : hA, xhB = last ? nhB : hB;
            PG8_LDB(B0, 0, 0); PG8_LDB(B1, 0, 1); PG8_SCHED; PG8_LDA(At, 0, 0); PG8_STAGE(PG8_SA(1, 1), a1 + hA, vA0, lA);
            PG8_WAIT_V(8); PG8_WAIT_L(0); PG8_BAR; PG8_MMA(0, 0, At, B0); PG8_MMA(0, 1, At, B1); PG8_BAR; PG8_SCHED;
            PG8_LDA(At, 0, 1); PG8_STAGE(PG8_SB(0, 0), b2, xB0, xlB); PG8_STAGE(PG8_SB(0, 1), b2 + xhB, xB0, xlB); PG8_STAGE(PG8_SA(0, 0), a2, xA0, xlA);
            PG8_WAIT_V(8); PG8_WAIT_L(0); PG8_BAR; PG8_MMA(1, 0, At, B0); PG8_MMA(1, 1, At, B1); PG8_BAR; PG8_SCHED;
            PG8_LDB(B0, 1, 0); PG8_LDB(B1, 1, 1); PG8_SCHED; PG8_LDA(At, 1, 0); PG8_STAGE(PG8_SA(0, 1), a2 + xhA, xA0, xlA);
            PG8_WAIT_V(8); PG8_WAIT_L(0); PG8_BAR; PG8_MMA(0, 0, At, B0); PG8_MMA(0, 1, At, B1); PG8_BAR; PG8_SCHED;
            PG8_LDA(At, 1, 1); PG8_STAGE(PG8_SB(1, 0), b3, xB0, xlB); PG8_STAGE(PG8_SB(1, 1), b3 + xhB, xB0, xlB); PG8_STAGE(PG8_SA(1, 0), a3, xA0, xlA);
            PG8_WAIT_V(8); PG8_WAIT_L(0); PG8_BAR; PG8_MMA(1, 0, At, B0); PG8_MMA(1, 1, At, B1); PG8_BAR; PG8_SCHED;
        }
        if (wr == 0) PG8_BAR;
        epilogue(acc, cur, E, tid, wr, wc, fr, fq);
        if (!has_next) break;
#pragma unroll
        for (int a = 0; a < 2; ++a)
#pragma unroll
            for (int b = 0; b < 2; ++b)
#pragma unroll
                for (int m = 0; m < 4; ++m)
#pragma unroll
                    for (int n = 0; n < 2; ++n) acc[a][b][m][n] = (f32x4){0.f, 0.f, 0.f, 0.f};
        cur = nxt; cA = nA; cB = nB; vA0 = nvA0; vB0 = nvB0; lA = nlda; lB = nldb; hA = nhA; hB = nhB; ++ui;
        if (wr == 1) PG8_BAR;
    }
    PG8_WAIT_V(0);
    PG8_BAR;
#undef PG8_SA
#undef PG8_SB
#undef PG8_STAGE
#undef PG8_LDA
#undef PG8_LDB
#undef PG8_MMA
#undef PG8_WAIT_V
#undef PG8_WAIT_L
#undef PG8_BAR
#undef PG8_SCHED
}
}

DI void tr_item(const float* src, int srcP, int srcCol, int k0, bf16_t* dst, int dstP, int dstRow, int dstK, LAS float* scr, int lane) {
    float tv[32];
#pragma unroll
    for (int i = 0; i < 32; ++i) { const int kk = 2 * i + (lane >> 5); tv[i] = __builtin_nontemporal_load(src + (size_t)(k0 + kk) * srcP + srcCol + (lane & 31)); }
#pragma unroll
    for (int i = 0; i < 32; ++i) { const int kk = 2 * i + (lane >> 5); scr[kk * 33 + (lane & 31)] = tv[i]; }
    asm volatile("s_waitcnt lgkmcnt(0)" ::: "memory");
    const int c = lane & 7;
#pragma unroll
    for (int j = 0; j < 4; ++j) { const int n = (lane >> 3) + 8 * j; const LAS float* s = scr + (8 * c) * 33 + n;
        u32x4 o; o.x = cvtpk(s[0 * 33], s[1 * 33]); o.y = cvtpk(s[2 * 33], s[3 * 33]); o.z = cvtpk(s[4 * 33], s[5 * 33]); o.w = cvtpk(s[6 * 33], s[7 * 33]);
        *(u32x4*)(dst + (size_t)(dstRow + n) * dstP + dstK + k0 + 8 * c) = o; }
    asm volatile("s_waitcnt lgkmcnt(0)" ::: "memory");
}
DI void tr_job(int r, const float* src, int srcP, int srcC, int N, bf16_t* dst, int dstP, int dstK, int upHalf, LAS float* scr, int lane) {
    const int nblk = N / 32, kb = r / nblk, nb = r - kb * nblk, n0 = nb * 32;
    const int dstRow = (upHalf >= 0) ? ((n0 >> 7) * 256 + upHalf * 128 + (n0 & 127)) : n0;
    tr_item(src, srcP, srcC + n0, kb * 64, dst, dstP, dstRow, dstK, scr, lane);
}
DI void convert_weights(int l, LAS unsigned char* lds, int gw, int ngw) {
    const KP p = kparams();
    const int lane = opaque_tid() & 63, wave = gw & 7;
    LAS float* scr = (LAS float*)(lds + wave * 16384);
    unsigned char* ws = p->ws;
    const float* w1a = p->in[3] + (size_t)l * DM * DFF; const float* w3a = p->in[4] + (size_t)l * DM * DFF; const float* w2a = p->in[5] + (size_t)l * DFF * DM;
    const float* w1b = p->in[22] + (size_t)l * DM * DFF; const float* w3b = p->in[23] + (size_t)l * DM * DFF; const float* w2b = p->in[24] + (size_t)l * DFF * DM;
    const float* win = p->in[7] + (size_t)l * DM * 8200;
    const float* wrg = p->in[17] + (size_t)l * 1024 * 1024; const float* wsb = p->in[18] + (size_t)l * 512 * 1024; const float* wfx = p->in[19] + (size_t)l * 512 * 1024;
    const float* wo = p->in[20] + (size_t)l * 1024 * 1024;
    constexpr int I_UP = 16 * 88, I_DN = 44 * 32, I_IN = 16 * 160, I_G = 16 * 96, I_RG = 16 * 32, I_SB = 8 * 32, I_O = 16 * 32;
    constexpr int NITEMS = 4 * I_UP + 2 * I_DN + I_IN + I_G + I_RG + 2 * I_SB + I_O;
    const int ipw = (NITEMS + ngw - 1) / ngw;
    for (int it = gw * ipw; it < (gw + 1) * ipw && it < NITEMS; ++it) {
        int r = it;
        if (r < I_UP) { tr_job(r, w1a, DFF, 0, DFF, (bf16_t*)(ws + WS_WUP1), 1024, 0, 0, scr, lane); continue; } r -= I_UP;
        if (r < I_UP) { tr_job(r, w3a, DFF, 0, DFF, (bf16_t*)(ws + WS_WUP1), 1024, 0, 1, scr, lane); continue; } r -= I_UP;
        if (r < I_DN) { tr_job(r, w2a, DM, 0, DM, (bf16_t*)(ws + WS_WDN1), DFF, 0, -1, scr, lane); continue; } r -= I_DN;
        if (r < I_UP) { tr_job(r, w1b, DFF, 0, DFF, (bf16_t*)(ws + WS_WUP2), 1024, 0, 0, scr, lane); continue; } r -= I_UP;
        if (r < I_UP) { tr_job(r, w3b, DFF, 0, DFF, (bf16_t*)(ws + WS_WUP2), 1024, 0, 1, scr, lane); continue; } r -= I_UP;
        if (r < I_DN) { tr_job(r, w2b, DM, 0, DM, (bf16_t*)(ws + WS_WDN2), DFF, 0, -1, scr, lane); continue; } r -= I_DN;
        if (r < I_IN) { tr_job(r, win, 8200, 0, 5120, (bf16_t*)(ws + WS_WIN), 1024, 0, -1, scr, lane); continue; } r -= I_IN;
        if (r < I_G) { tr_job(r, win, 8200, 5128, 3072, (bf16_t*)(ws + WS_WG), 1024, 0, -1, scr, lane); continue; } r -= I_G;
        if (r < I_RG) { tr_job(r, wrg, 1024, 0, 1024, (bf16_t*)(ws + WS_WM), 2048, 0, -1, scr, lane); continue; } r -= I_RG;
        if (r < I_SB) { tr_job(r, wsb, 1024, 0, 1024, (bf16_t*)(ws + WS_WM), 2048, 1024, -1, scr, lane); continue; } r -= I_SB;
        if (r < I_SB) { tr_job(r, wfx, 1024, 0, 1024, (bf16_t*)(ws + WS_WM), 2048, 1536, -1, scr, lane); continue; } r -= I_SB;
        tr_job(r, wo, 1024, 0, 1024, (bf16_t*)(ws + WS_WO), 1024, 0, -1, scr, lane);
    }
}

DI void ada_unit(int u, LAS unsigned char* lds) {
    const KP p = kparams();
    const int tid = opaque_tid();
    LAS float* cT = (LAS float*)lds;
    LAS float* red = (LAS float*)(lds + 65536);
    const float* c = p->in[1];
    for (int i = tid; i < NB * DM; i += NTHR) { const int b = i >> 10, k = i & 1023; const float v = c[i]; cT[k * 16 + b] = v * sigmoidf(v); }
    __syncthreads();
    const float* W; const float* bias; float* out; int pitch, j0;
    if (u < 144) { const int l = u / 72, uu = u - l * 72; j0 = uu * 128; pitch = NADA; W = p->in[25] + (size_t)l * DM * NADA; bias = p->in[26] + (size_t)l * NADA; out = (float*)(p->ws + WS_MOD) + (size_t)l * NB * NADA; }
    else { j0 = (u - 144) * 128; pitch = 2048; W = p->in[28]; bias = p->in[29]; out = (float*)(p->ws + WS_FM); }
    const int col = tid & 127, q = tid >> 7;
    float acc[16];
#pragma unroll
    for (int b = 0; b < 16; ++b) acc[b] = 0.f;
    const float* wp = W + (size_t)(q * 256) * pitch + j0 + col;
    for (int k0 = 0; k0 < 256; k0 += 16) {
        float wv[16];
#pragma unroll
        for (int kk = 0; kk < 16; ++kk) wv[kk] = __builtin_nontemporal_load(wp + (size_t)(k0 + kk) * pitch);
#pragma unroll
        for (int kk = 0; kk < 16; ++kk) {
            const float w = wv[kk];
            const LAS f32x4* cp = (const LAS f32x4*)(cT + (q * 256 + k0 + kk) * 16);
            const f32x4 c0 = cp[0], c1 = cp[1], c2 = cp[2], c3 = cp[3];
            acc[0] += c0[0] * w; acc[1] += c0[1] * w; acc[2] += c0[2] * w; acc[3] += c0[3] * w;
            acc[4] += c1[0] * w; acc[5] += c1[1] * w; acc[6] += c1[2] * w; acc[7] += c1[3] * w;
            acc[8] += c2[0] * w; acc[9] += c2[1] * w; acc[10] += c2[2] * w; acc[11] += c2[3] * w;
            acc[12] += c3[0] * w; acc[13] += c3[1] * w; acc[14] += c3[2] * w; acc[15] += c3[3] * w;
        }
    }
#pragma unroll
    for (int b = 0; b < 16; ++b) red[(q * 16 + b) * 128 + col] = acc[b];
    __syncthreads();
    for (int i = tid; i < 16 * 128; i += NTHR) { const int b = i >> 7, cc = i & 127;
        const float s = red[(0 * 16 + b) * 128 + cc] + red[(1 * 16 + b) * 128 + cc] + red[(2 * 16 + b) * 128 + cc] + red[(3 * 16 + b) * 128 + cc];
        out[(size_t)b * pitch + j0 + cc] = s + bias[j0 + cc]; }
    __syncthreads();
}

DI void norm_phase(int l, int mode, int sub, LAS unsigned char* lds, int gw, int ngw, int dsub = -1, int dl = 0) {
    const KP p = kparams();
    const int lane = opaque_tid() & 63;
    const float* xin = p->in[0];
    bf16_t* xb = (bf16_t*)(p->ws + WS_XB);
    const bf16_t* dsrc = (mode == 3) ? (const bf16_t*)(p->ws + WS_DLAST) : (const bf16_t*)p->out;
    const float* gain = (mode == 3) ? p->in[27] : ((sub == 0 ? p->in[2] : (sub == 1 ? p->in[6] : p->in[21])) + (size_t)l * DM);
    const float* mod = (mode == 3) ? (const float*)(p->ws + WS_FM) : ((const float*)(p->ws + WS_MOD) + (size_t)l * NB * NADA + sub * 3072);
    const int mpitch = (mode == 3) ? 2048 : NADA;
    bf16_t* hout = (bf16_t*)p->out;
    LAS float* wfT = (LAS float*)lds;
    if (mode == 2) {
        const float* win = p->in[7] + (size_t)l * DM * 8200 + 5120;
        for (int i = opaque_tid(); i < 8192; i += NTHR) { const int k = i >> 3, j = i & 7; wfT[j * 1024 + k] = win[(size_t)k * 8200 + j]; }
        __syncthreads();
    }
    f32x4 g[4];
#pragma unroll
    for (int j = 0; j < 4; ++j) g[j] = *(const f32x4*)(gain + 4 * lane + 256 * j);
    constexpr int RPW = 4;
    const int rows_per_wave = M / ngw;
    const int mw0 = gw * rows_per_wave, b = mw0 >> 11;
    f32x4 sh[4], sc[4], gt[4];
    {
        const float* mp = mod + (size_t)b * mpitch + 4 * lane;
        const float coef = (dsub == 1) ? 1.0f : 0.5f;
        const float* gp = (const float*)(p->ws + WS_MOD) + (size_t)dl * NB * NADA + (size_t)b * NADA + (dsub >= 0 ? dsub : 0) * 3072 + 2048 + 4 * lane;
        f32x4 t0[4], t1[4], t2[4];
#pragma unroll
        for (int j = 0; j < 4; ++j) { t0[j] = *(const f32x4*)(mp + 256 * j); t1[j] = *(const f32x4*)(mp + 1024 + 256 * j); t2[j] = *(const f32x4*)(gp + 256 * j); }
#pragma unroll
        for (int j = 0; j < 4; ++j) { sh[j] = t0[j]; sc[j] = (t1[j] + 1.0f) * g[j]; gt[j] = (t2[j] + 1.0f) * coef; }
    }
    for (int m0 = mw0; m0 < mw0 + rows_per_wave; m0 += RPW) {
        f32x4 v[RPW][4]; u32x2 dw[RPW][4];
        if (mode == 1) {
#pragma unroll
            for (int i = 0; i < RPW; ++i)
#pragma unroll
                for (int j = 0; j < 4; ++j) v[i][j] = *(const f32x4*)(xin + (size_t)(m0 + i) * DM + 4 * lane + 256 * j);
        } else {
#pragma unroll
            for (int i = 0; i < RPW; ++i)
#pragma unroll
                for (int j = 0; j < 4; ++j) { const u32x2 xw = __builtin_nontemporal_load((const u32x2*)(xb + (size_t)(m0 + i) * DM + 4 * lane + 256 * j)); v[i][j] = (f32x4){bf_lo(xw.x), bf_hi(xw.x), bf_lo(xw.y), bf_hi(xw.y)}; }
        }
        if (dsub >= 0) {
#pragma unroll
            for (int i = 0; i < RPW; ++i)
#pragma unroll
                for (int j = 0; j < 4; ++j) dw[i][j] = __builtin_nontemporal_load((const u32x2*)(dsrc + (size_t)(m0 + i) * DM + 4 * lane + 256 * j));
#pragma unroll
            for (int j = 0; j < 4; ++j)
#pragma unroll
                for (int i = 0; i < RPW; ++i) { v[i][j][0] += gt[j][0] * bf_lo(dw[i][j].x); v[i][j][1] += gt[j][1] * bf_hi(dw[i][j].x); v[i][j][2] += gt[j][2] * bf_lo(dw[i][j].y); v[i][j][3] += gt[j][3] * bf_hi(dw[i][j].y); }
        }
        float ss[RPW];
#pragma unroll
        for (int i = 0; i < RPW; ++i) { float t = 0.f;
#pragma unroll
            for (int j = 0; j < 4; ++j) t += (v[i][j][0] * v[i][j][0] + v[i][j][1] * v[i][j][1]) + (v[i][j][2] * v[i][j][2] + v[i][j][3] * v[i][j][3]);
            ss[i] = t; }
        if (mode == 1 || (dsub >= 0 && mode != 3)) {
#pragma unroll
            for (int i = 0; i < RPW; ++i)
#pragma unroll
                for (int j = 0; j < 4; ++j) { u32x2 w; w.x = cvtpk(v[i][j][0], v[i][j][1]); w.y = cvtpk(v[i][j][2], v[i][j][3]); __builtin_nontemporal_store(w, (u32x2*)(xb + (size_t)(m0 + i) * DM + 4 * lane + 256 * j)); }
        }
#pragma unroll
        for (int o = 1; o < 64; o <<= 1) {
#pragma unroll
            for (int i = 0; i < RPW; ++i) ss[i] += __shfl_xor(ss[i], o);
        }
#pragma unroll
        for (int i = 0; i < RPW; ++i) {
            const int m = m0 + i;
            const float r = 1.0f / sqrtf(ss[i] * (1.0f / DM) + EPS);
            f32x4 hv[4];
#pragma unroll
            for (int j = 0; j < 4; ++j) hv[j] = (v[i][j] * r) * sc[j] + sh[j];
            if (mode == 3) {
#pragma unroll
                for (int j = 0; j < 4; ++j) *(f32x4*)(p->out + (size_t)m * DM + 4 * lane + 256 * j) = hv[j];
            } else {
#pragma unroll
                for (int j = 0; j < 4; ++j) { u32x2 w; w.x = cvtpk(hv[j][0], hv[j][1]); w.y = cvtpk(hv[j][2], hv[j][3]); *(u32x2*)(hout + (size_t)m * DM + 4 * lane + 256 * j) = w; }
            }
            if (mode == 2) {
                float d[8];
                const LAS float* wq = wfT + 4 * lane; asm volatile("" : "+v"(wq));
#pragma unroll
                for (int jj = 0; jj < 8; ++jj) { float s = 0.f;
#pragma unroll
                    for (int j = 0; j < 4; ++j) { const f32x4 w = *(const LAS f32x4*)(wq + jj * 1024 + 256 * j); s += (hv[j][0] * w[0] + hv[j][1] * w[1]) + (hv[j][2] * w[2] + hv[j][3] * w[3]); }
                    d[jj] = s; }
#pragma unroll
                for (int o = 1; o < 64; o <<= 1) {
#pragma unroll
                    for (int jj = 0; jj < 8; ++jj) d[jj] += __shfl_xor(d[jj], o);
                }
                if (lane < 8) { float dv = d[0];
#pragma unroll
                    for (int jj = 1; jj < 8; ++jj) dv = (lane == jj) ? d[jj] : dv;
                    const float z = dv + p->in[15][l * 8 + lane];
                    const float ls = -(fmaxf(-z, 0.f) + log1pf(__expf(-fabsf(z))));
                    ((float*)(p->ws + WS_LOGF))[((size_t)b * 8 + lane) * SEQ + (m & (SEQ - 1))] = ls; }
            }
        }
    }
    if (mode == 2) __syncthreads();
}

constexpr int RG_TC = 128, RG_P = 66;
constexpr int RG_RGX = 0;
constexpr int RG_XAB = 2 * 16768;
constexpr int RG_WAT = RG_XAB + 18432;
constexpr int RG_WXT = RG_WAT + 9216;
constexpr int RG_AS = RG_WXT + 9216;
constexpr int RG_US = RG_AS + 33792;
constexpr int RG_CARRY = RG_US + 33792;
constexpr int RG_HST = RG_CARRY + 8192;
static_assert(RG_HST + 512 <= LDS_CTL, "rg lds");

DI void rg_unit(int l, int b, int n, LAS unsigned char* lds, int dry = 0) {
    const KP p = kparams();
    const int tid = opaque_tid(), lane = tid & 63, wid = __builtin_amdgcn_readfirstlane(tid >> 6);
    bf16_t* proj = (bf16_t*)(p->ws + WS_PROJ);
    const int c0 = n * 64;
    const float* convw = p->in[8] + (size_t)l * 4 * 1024; const float* convb = p->in[9] + (size_t)l * 1024;
    const float* wa = p->in[10] + ((size_t)l * 16 + n) * 4096; const float* wx = p->in[12] + ((size_t)l * 16 + n) * 4096;
    const float* ba = p->in[11] + (size_t)l * 1024 + c0; const float* bx = p->in[13] + (size_t)l * 1024 + c0; const float* lam = p->in[14] + (size_t)l * 1024 + c0;
    LAS bf16_t* xab = (LAS bf16_t*)(lds + RG_XAB);
    LAS bf16_t* wat = (LAS bf16_t*)(lds + RG_WAT); LAS bf16_t* wxt = (LAS bf16_t*)(lds + RG_WXT);
    LAS float* As = (LAS float*)(lds + RG_AS); LAS float* Us = (LAS float*)(lds + RG_US);
    LAS float* hst = (LAS float*)(lds + RG_HST);
    const size_t rowbase = (size_t)b * SEQ;
    const int pr0 = tid >> 3, pc = tid & 7;
    const bf16_t* xsrc = proj + rowbase * PP + c0 + pc * 8;
    u32x4 x0, x1, x2;
    { const u32x4 z4 = (u32x4){0u, 0u, 0u, 0u};
      x0 = (pr0 - 3 >= 0) ? *(const u32x4*)(xsrc + (size_t)(pr0 - 3) * PP) : z4;
      x1 = *(const u32x4*)(xsrc + (size_t)(pr0 + 64 - 3) * PP);
      x2 = z4; if (tid < 24) x2 = *(const u32x4*)(xsrc + (size_t)(pr0 + 128 - 3) * PP); }
    for (int i = tid; i < 4096; i += NTHR) { const int d = i >> 6, e = i & 63; wat[e * 72 + d] = f2bf(wa[i]); wxt[e * 72 + d] = f2bf(wx[i]); }
    if (tid < 128) hst[tid] = 0.f;
    const float cw0 = convw[c0 + lane], cw1 = convw[1024 + c0 + lane], cw2 = convw[2048 + c0 + lane], cw3 = convw[3072 + c0 + lane], cbv = convb[c0 + lane];
    float bae[4], bxe[4], spe[4];
#pragma unroll
    for (int ei = 0; ei < 4; ++ei) { const int e = 16 * ei + (lane & 15); bae[ei] = ba[e]; bxe[ei] = bx[e]; const float lm = lam[e];
        spe[ei] = -8.0f * (fmaxf(-lm, 0.f) + log1pf(__expf(-fabsf(lm)))); }
    { LAS bf16_t* rg0 = (LAS bf16_t*)(lds + RG_RGX);
      *(LAS u32x4*)(rg0 + pr0 * 64 + pc * 8) = x0; *(LAS u32x4*)(rg0 + (pr0 + 64) * 64 + pc * 8) = x1; if (tid < 24) *(LAS u32x4*)(rg0 + (pr0 + 128) * 64 + pc * 8) = x2; }
    __syncthreads();
#define LDS_BAR() do { asm volatile("s_waitcnt lgkmcnt(0)" ::: "memory"); __builtin_amdgcn_s_barrier(); asm volatile("" ::: "memory"); } while (0)
#define LDS_WAVE() asm volatile("s_waitcnt lgkmcnt(0)" ::: "memory")
    for (int ch = 0; ch < SEQ / RG_TC; ++ch) {
        const int t0 = ch * RG_TC, par = ch & 1;
        const LAS bf16_t* rgx = (const LAS bf16_t*)(lds + RG_RGX + par * 16768);
        LAS bf16_t* rgn = (LAS bf16_t*)(lds + RG_RGX + (par ^ 1) * 16768);
        LAS float* carry = (LAS float*)(lds + RG_CARRY + par * 4096);
        bf16_t* gp = proj + (rowbase + t0 + 16 * wid) * PP + 1024 + c0 + lane;
        unsigned gq[16];
#pragma unroll
        for (int s2 = 0; s2 < 16; ++s2) gq[s2] = gp[(size_t)s2 * PP];
        const bool more = ch + 1 < SEQ / RG_TC;
        if (more) { const bf16_t* xs = xsrc + (size_t)(t0 + RG_TC - 3) * PP;
            x0 = *(const u32x4*)(xs + (size_t)pr0 * PP); x1 = *(const u32x4*)(xs + (size_t)(pr0 + 64) * PP); if (tid < 24) x2 = *(const u32x4*)(xs + (size_t)(pr0 + 128) * PP); }
        {
            const LAS bf16_t* rp = rgx + (16 * wid) * 64 + lane;
            float v0 = bf1(rp[0]), v1 = bf1(rp[64]), v2 = bf1(rp[128]);
#pragma unroll
            for (int i = 0; i < 16; ++i) { const int t = 16 * wid + i; const float v3 = bf1(rp[(i + 3) * 64]);
                const float xa = cbv + cw0 * v0 + cw1 * v1 + cw2 * v2 + cw3 * v3;
                Us[t * RG_P + lane] = xa; xab[t * 72 + lane] = f2bf(xa); v0 = v1; v1 = v2; v2 = v3; }
        }
        LDS_WAVE();
        {
            const int row = lane & 15, quad = lane >> 4;
            const bf16x8 a0 = *(const LAS bf16x8*)(xab + (16 * wid + row) * 72 + quad * 8), a1 = *(const LAS bf16x8*)(xab + (16 * wid + row) * 72 + 32 + quad * 8);
#pragma unroll
            for (int ei = 0; ei < 4; ++ei) {
                const bf16x8 ba0 = *(const LAS bf16x8*)(wat + (16 * ei + row) * 72 + quad * 8), ba1 = *(const LAS bf16x8*)(wat + (16 * ei + row) * 72 + 32 + quad * 8);
                const bf16x8 bx0 = *(const LAS bf16x8*)(wxt + (16 * ei + row) * 72 + quad * 8), bx1 = *(const LAS bf16x8*)(wxt + (16 * ei + row) * 72 + 32 + quad * 8);
                f32x4 rr = (f32x4){0.f, 0.f, 0.f, 0.f}, ii = (f32x4){0.f, 0.f, 0.f, 0.f};
                rr = MFMA16(a0, ba0, rr); rr = MFMA16(a1, ba1, rr);
                ii = MFMA16(a0, bx0, ii); ii = MFMA16(a1, bx1, ii);
#pragma unroll
                for (int jj = 0; jj < 4; ++jj) { const int t = 16 * wid + quad * 4 + jj, e = 16 * ei + row;
                    const float r = sigmoidf(rr[jj] + bae[ei]), ig = sigmoidf(ii[jj] + bxe[ei]);
                    const float la = r * spe[ei];
                    const float a = fexp2(la * LOG2E);
                    const float x2l = 2.0f * la;
                    const float ser = -x2l * (1.0f + x2l * (0.5f + x2l * (0.16666667f + x2l * (0.041666668f + x2l * (0.0083333338f + x2l * 0.0013888889f)))));
                    const float om = (x2l > -0.5f) ? ser : (1.0f - a * a);
                    const float sq = sqrtf(om);
                    const float xa = Us[t * RG_P + e];
                    Us[t * RG_P + e] = sq * ig * xa; As[t * RG_P + e] = a; }
            }
        }
        LDS_WAVE();
        {
            float P = 1.f, H = 0.f;
#pragma unroll
            for (int s2 = 0; s2 < 16; ++s2) { const int t = 16 * wid + s2; const float a = As[t * RG_P + lane], u = Us[t * RG_P + lane]; H = a * H + u; P *= a; }
            carry[(wid * 64 + lane) * 2] = P; carry[(wid * 64 + lane) * 2 + 1] = H;
            if (more) { *(LAS u32x4*)(rgn + pr0 * 64 + pc * 8) = x0; *(LAS u32x4*)(rgn + (pr0 + 64) * 64 + pc * 8) = x1; if (tid < 24) *(LAS u32x4*)(rgn + (pr0 + 128) * 64 + pc * 8) = x2; }
        }
        LDS_BAR();
        {
            float h = hst[par * 64 + lane];
            for (int s2 = 0; s2 < wid; ++s2) h = carry[(s2 * 64 + lane) * 2] * h + carry[(s2 * 64 + lane) * 2 + 1];
#pragma unroll
            for (int s2 = 0; s2 < 16; ++s2) { const int t = 16 * wid + s2; const float a = As[t * RG_P + lane], u = Us[t * RG_P + lane]; h = a * h + u;
                const float gx = bf1((bf16_t)gq[s2]);
                const float y2 = 1.5957691216f * (gx + 0.044715f * gx * gx * gx);
                const float ge = gx * sigmoidf(y2);
                if (!dry) gp[(size_t)s2 * PP] = f2bf(ge * h); }
            if (wid == 7) hst[(par ^ 1) * 64 + lane] = h;
        }
    }
    LDS_BAR();
#undef LDS_BAR
#undef LDS_WAVE
}

constexpr int AT_K = 0, AT_V = 18432, AT_BIAS = 36864, AT_SCAN = AT_BIAS + 8192;
DI int crow(int r, int h) { return (r & 3) + 8 * (r >> 2) + 4 * h; }
DI s16x4 vtr(const LAS unsigned char* pp) { typedef short v4i16_t __attribute__((ext_vector_type(4))); return __builtin_bit_cast(s16x4, __builtin_amdgcn_ds_read_tr16_b64_v4i16((LAS v4i16_t*)pp)); }

template <bool SB>
DI void attn_unit(int b, int h, int qb, LAS unsigned char* lds, int dry = 0) {
    const KP p = kparams();
    const int tid = opaque_tid(), lane = tid & 63, wid = __builtin_amdgcn_readfirstlane(tid >> 6), r32 = lane & 31, hi = lane >> 5;
    bf16_t* proj = (bf16_t*)(p->ws + WS_PROJ);
    const int colQ = (SB ? 2048 : 3584) + h * 64, colK = colQ + 512, colV = colQ + 1024;
    const size_t rowbase = (size_t)b * SEQ;
    const int qmin = qb * 256 + wid * 32, qmax = qmin + 31, qrow = qmin + r32;
    const int NT = 4 * (qb + 1);
    LAS float* bias = (LAS float*)(lds + AT_BIAS);
    bf16x8 qr[4];
    { const bf16_t* qp = proj + (rowbase + qrow) * PP + colQ + hi * 8;
#pragma unroll
      for (int d0 = 0; d0 < 4; ++d0) qr[d0] = *(const bf16x8*)(qp + d0 * 16); }
    const int srow = tid >> 3, sch = tid & 7;
    const bf16_t* kg = proj + (rowbase + srow) * PP + colK + sch * 8;
    const bf16_t* vg = proj + (rowbase + srow) * PP + colV + sch * 8;
    const int soff = srow * 144 + sch * 16;
    const int jfirst = SB ? NT - 1 : 0;
    const u32x4 kreg0 = *(const u32x4*)(kg + (size_t)jfirst * 64 * PP), vreg0 = *(const u32x4*)(vg + (size_t)jfirst * 64 * PP);
    if (!SB) {
        const float* lf = (const float*)(p->ws + WS_LOGF) + ((size_t)b * 8 + h) * SEQ;
        LAS float* scanw = (LAS float*)(lds + AT_SCAN);
        const int n = 256 * (qb + 1);
        f32x4 v = (f32x4){0.f, 0.f, 0.f, 0.f};
        if (4 * tid < n) v = *(const f32x4*)(lf + 4 * tid);
        const float s1 = v[0], s2 = s1 + v[1], s3 = s2 + v[2], s4 = s3 + v[3];
        float sc = s4;
#pragma unroll
        for (int o = 1; o < 64; o <<= 1) { const float t = __shfl_up(sc, o); if (lane >= o) sc += t; }
        if (lane == 63) scanw[wid] = sc;
        __syncthreads();
        float off = sc - s4;
        for (int w = 0; w < wid; ++w) off += scanw[w];
        if (4 * tid < n) { f32x4 o; o[0] = -(off + s1) * LOG2E; o[1] = -(off + s2) * LOG2E; o[2] = -(off + s3) * LOG2E; o[3] = -(off + s4) * LOG2E; *(LAS f32x4*)(bias + 4 * tid) = o; }
    }
    *(LAS u32x4*)(lds + AT_K + soff) = kreg0; *(LAS u32x4*)(lds + AT_V + soff) = vreg0;
    __syncthreads();
    f32x16 y0, y1;
#pragma unroll
    for (int i = 0; i < 16; ++i) { y0[i] = 0.f; y1[i] = 0.f; }
    float mrun = -INFINITY, lrun = 0.f, carry = 0.f;
    LAS unsigned* xflag = (LAS unsigned*)(lds + AT_SCAN + 64);
    for (int it = 0; it < NT; ++it) {
        const int j = SB ? NT - 1 - it : it, buf = it & 1;
        const bool more = it + 1 < NT; const int jn = SB ? j - 1 : j + 1;
        u32x4 kreg, vreg;
        if (more) { kreg = *(const u32x4*)(kg + (size_t)jn * 64 * PP); vreg = *(const u32x4*)(vg + (size_t)jn * 64 * PP); }
        if (64 * j <= qmax && !(SB && __all(carry > 160.0f))) {
            const LAS unsigned char* Kb = lds + AT_K + buf * 9216; const LAS unsigned char* Vb = lds + AT_V + buf * 9216;
            f32x16 p0, p1;
            if (SB) {
#pragma unroll
                for (int i = 0; i < 16; ++i) { p0[i] = 0.f; p1[i] = 0.f; }
            } else {
                const LAS float* bp = bias + 64 * j + 4 * hi;
#pragma unroll
                for (int g = 0; g < 4; ++g) { const f32x4 t0 = *(const LAS f32x4*)(bp + 8 * g), t1 = *(const LAS f32x4*)(bp + 32 + 8 * g);
                    p0[4 * g] = t0[0]; p0[4 * g + 1] = t0[1]; p0[4 * g + 2] = t0[2]; p0[4 * g + 3] = t0[3];
                    p1[4 * g] = t1[0]; p1[4 * g + 1] = t1[1]; p1[4 * g + 2] = t1[2]; p1[4 * g + 3] = t1[3]; }
            }
#pragma unroll
            for (int d0 = 0; d0 < 4; ++d0) {
                const bf16x8 k0 = *(const LAS bf16x8*)(Kb + r32 * 144 + d0 * 32 + hi * 16), k1 = *(const LAS bf16x8*)(Kb + (32 + r32) * 144 + d0 * 32 + hi * 16);
                p0 = MFMA32(k0, qr[d0], p0); p1 = MFMA32(k1, qr[d0], p1);
            }
            const bool band = (64 * j + 63 >= qmin);
            if (SB) {
                float c0[16], c1[16];
#pragma unroll
                for (int i = 0; i < 16; ++i) {
                    const float z0 = p0[i], z1 = p1[i];
                    float a0 = fmaxf(z0, 0.f) + flog2(1.f + fexp2(-fabsf(z0))), a1 = fmaxf(z1, 0.f) + flog2(1.f + fexp2(-fabsf(z1)));
                    if (band) { const int kv = 64 * j + crow(i, hi); if (kv >= qrow) a0 = 0.f; if (kv + 32 >= qrow) a1 = 0.f; }
                    c0[i] = a0; c1[i] = a1;
                }
                float pr[8], tg[8];
#pragma unroll
                for (int g = 0; g < 4; ++g) { const float s0 = (c0[4 * g] + c0[4 * g + 1]) + (c0[4 * g + 2] + c0[4 * g + 3]), s1 = (c1[4 * g] + c1[4 * g + 1]) + (c1[4 * g + 2] + c1[4 * g + 3]);
                    tg[g] = __shfl_xor(s0, 32); tg[4 + g] = __shfl_xor(s1, 32); pr[g] = s0 + tg[g]; pr[4 + g] = s1 + tg[4 + g]; }
                float ps = 0.f;
#pragma unroll
                for (int g = 7; g >= 0; --g) {
                    const float sufex = carry + ps + (hi == 0 ? tg[g] : 0.f);
                    if (g >= 4) { const int gi = 4 * (g - 4);
                        const float C3 = sufex + c1[gi + 3], C2_ = C3 + c1[gi + 2], C1 = C2_ + c1[gi + 1], C0 = C1 + c1[gi];
                        p1[gi + 3] = fexp2(p1[gi + 3] - C3); p1[gi + 2] = fexp2(p1[gi + 2] - C2_); p1[gi + 1] = fexp2(p1[gi + 1] - C1); p1[gi] = fexp2(p1[gi] - C0);
                    } else { const int gi = 4 * g;
                        const float C3 = sufex + c0[gi + 3], C2_ = C3 + c0[gi + 2], C1 = C2_ + c0[gi + 1], C0 = C1 + c0[gi];
                        p0[gi + 3] = fexp2(p0[gi + 3] - C3); p0[gi + 2] = fexp2(p0[gi + 2] - C2_); p0[gi + 1] = fexp2(p0[gi + 1] - C1); p0[gi] = fexp2(p0[gi] - C0);
                    }
                    ps += pr[g];
                }
                carry += ps;
                if (band) {
#pragma unroll
                    for (int i = 0; i < 16; ++i) { const int kv = 64 * j + crow(i, hi); if (kv >= qrow) p0[i] = 0.f; if (kv + 32 >= qrow) p1[i] = 0.f; }
                }
            } else {
                if (band) {
#pragma unroll
                    for (int i = 0; i < 16; ++i) { const int kv = 64 * j + crow(i, hi); if (kv > qrow) p0[i] = -INFINITY; if (kv + 32 > qrow) p1[i] = -INFINITY; }
                }
                float rm = __builtin_fmaxf(p0[0], p1[0]), rm2 = __builtin_fmaxf(p0[1], p1[1]);
#pragma unroll
                for (int i = 2; i < 16; i += 2) { rm = __builtin_fmaxf(__builtin_fmaxf(rm, p0[i]), p1[i]); rm2 = __builtin_fmaxf(__builtin_fmaxf(rm2, p0[i + 1]), p1[i + 1]); }
                rm = __builtin_fmaxf(rm, rm2);
                rm = fmaxf(rm, __shfl_xor(rm, 32));
                if (__any(rm > mrun + 8.0f)) {
                    const float mnew = fmaxf(mrun, rm);
                    const float alpha = fexp2(mrun - mnew);
                    mrun = mnew; lrun *= alpha;
#pragma unroll
                    for (int i = 0; i < 16; ++i) { y0[i] *= alpha; y1[i] *= alpha; }
                }
                float rs = 0.f;
#pragma unroll
                for (int i = 0; i < 16; ++i) { p0[i] = fexp2(p0[i] - mrun); p1[i] = fexp2(p1[i] - mrun); rs += p0[i] + p1[i]; }
                lrun += rs;
            }
            const LAS unsigned char* vb = Vb + (4 * hi + ((lane & 15) >> 2)) * 144 + (16 * ((lane >> 4) & 1) + 4 * (lane & 3)) * 2;
#pragma unroll
            for (int pq = 0; pq < 2; ++pq)
#pragma unroll
                for (int ss = 0; ss < 2; ++ss) {
                    u32x4 pw;
                    if (pq == 0) { pw.x = cvtpk(p0[8 * ss], p0[8 * ss + 1]); pw.y = cvtpk(p0[8 * ss + 2], p0[8 * ss + 3]); pw.z = cvtpk(p0[8 * ss + 4], p0[8 * ss + 5]); pw.w = cvtpk(p0[8 * ss + 6], p0[8 * ss + 7]); }
                    else { pw.x = cvtpk(p1[8 * ss], p1[8 * ss + 1]); pw.y = cvtpk(p1[8 * ss + 2], p1[8 * ss + 3]); pw.z = cvtpk(p1[8 * ss + 4], p1[8 * ss + 5]); pw.w = cvtpk(p1[8 * ss + 6], p1[8 * ss + 7]); }
                    const bf16x8 xs = __builtin_bit_cast(bf16x8, pw);
                    const LAS unsigned char* vr = vb + (32 * pq + 16 * ss) * 144;
                    const s16x4 l0 = vtr(vr), h0 = vtr(vr + 8 * 144), l1 = vtr(vr + 64), h1 = vtr(vr + 8 * 144 + 64);
                    const bf16x8 pa0 = __builtin_shufflevector(l0, h0, 0, 1, 2, 3, 4, 5, 6, 7), pa1 = __builtin_shufflevector(l1, h1, 0, 1, 2, 3, 4, 5, 6, 7);
                    y0 = MFMA32(pa0, xs, y0); y1 = MFMA32(pa1, xs, y1);
                }
        }
        if (more) { *(LAS u32x4*)(lds + AT_K + (buf ^ 1) * 9216 + soff) = kreg; *(LAS u32x4*)(lds + AT_V + (buf ^ 1) * 9216 + soff) = vreg; }
        if (SB) {
            const bool sat = __all(carry > 160.0f);
            if (lane == 0) xflag[buf * 8 + wid] = sat ? 1u : 0u;
        }
        __syncthreads();
        if (SB) {
            unsigned allsat = 1u;
#pragma unroll
            for (int w = 0; w < 8; ++w) allsat &= xflag[buf * 8 + w];
            if (allsat) break;
        }
    }
    float inv = 1.f;
    if (!SB) { const float lt = lrun + __shfl_xor(lrun, 32); inv = 1.0f / lt; }
    bf16_t* op = proj + (rowbase + qrow) * PP + colQ + 4 * hi;
#pragma unroll
    for (int g = 0; g < 4; ++g) {
        u32x2 w0, w1;
        w0.x = cvtpk(y0[4 * g] * inv, y0[4 * g + 1] * inv); w0.y = cvtpk(y0[4 * g + 2] * inv, y0[4 * g + 3] * inv);
        w1.x = cvtpk(y1[4 * g] * inv, y1[4 * g + 1] * inv); w1.y = cvtpk(y1[4 * g + 2] * inv, y1[4 * g + 3] * inv);
        if (!dry) { *(u32x2*)(op + 8 * g) = w0; *(u32x2*)(op + 32 + 8 * g) = w1; }
    }
}


#define XB_TMO      128
#define XB_XCNT(j)  (256  + 64 * (j))
#define XB_XSUB(j)  (1280 + 64 * (j))
#define XB_XGEN(j)  (2304 + 64 * (j))
#define XB_TOP      3328
#define XB_TOPGEN   3392
#define XCD_BAR_WORDS 3456
#define XB_SPIN_CAP (1u << 18)
DI unsigned xb_ld(unsigned* p)              { return __hip_atomic_load(p, __ATOMIC_RELAXED, __HIP_MEMORY_SCOPE_AGENT); }
DI unsigned xb_add(unsigned* p, unsigned v) { return __hip_atomic_fetch_add(p, v, __ATOMIC_RELAXED, __HIP_MEMORY_SCOPE_AGENT); }
DI unsigned xb_xcc_id() { return (unsigned)__builtin_amdgcn_s_getreg((3 << 11) | 20) & 0xFu; }
#define XB_SPIN(cond, bar) do { unsigned _sp = 0; while (cond) { __builtin_amdgcn_s_sleep(1); \
    if ((++_sp & 255u) == 0u) { if (xb_ld(&(bar)[XB_TMO])) break; if (_sp > XB_SPIN_CAP) { atomicAdd(&(bar)[XB_TMO], 1u); break; } } } } while (0)
struct XcdBarrier { unsigned* bar; unsigned x; volatile LAS unsigned* st; };
DI XcdBarrier xcd_barrier_post(unsigned* bar, volatile LAS unsigned* st) {
    XcdBarrier b; b.bar = bar; b.x = xb_xcc_id(); b.st = st;
    if (threadIdx.x == 0) (void)xb_add(&bar[XB_XCNT(b.x)], 1u);
    return b;
}
DI void xcd_barrier_complete(unsigned* bar, unsigned x, unsigned& nloc, unsigned& nx) {
    const unsigned G = gridDim.x * gridDim.y * gridDim.z;
    unsigned sum, cnt, mine, sp = 0u;
    for (;;) {
        sum = 0u; cnt = 0u; mine = 0u;
#pragma unroll
        for (unsigned j = 0; j < 16; ++j) { const unsigned c = xb_ld(&bar[XB_XCNT(j)]); sum += c; cnt += (c > 0u) ? 1u : 0u; mine = (j == x) ? c : mine; }
        if (sum == G) break;
        __builtin_amdgcn_s_sleep(1);
        if ((++sp & 255u) == 0u) { if (xb_ld(&bar[XB_TMO])) break; if (sp > XB_SPIN_CAP) { atomicAdd(&bar[XB_TMO], 1u); break; } }
    }
    nloc = mine > 0u ? mine : 1u; nx = cnt > 0u ? cnt : 1u;
}
DI void xcd_barrier(const XcdBarrier& b) {
    asm volatile("s_waitcnt vmcnt(0)" ::: "memory");
    __syncthreads();
    if (threadIdx.x == 0) {
        unsigned* bar = b.bar;
        __builtin_amdgcn_s_waitcnt(0);
        unsigned nloc = b.st[0], nx = b.st[1];
        if (nloc == 0u) { xcd_barrier_complete(bar, b.x, nloc, nx); b.st[0] = nloc; b.st[1] = nx; }
        const unsigned old = xb_add(&bar[XB_XSUB(b.x)], 1u);
        const unsigned gen = old / nloc;
        if (old + 1u == (gen + 1u) * nloc) {
            __builtin_amdgcn_fence(__ATOMIC_RELEASE, "agent");
            asm volatile("s_waitcnt vmcnt(0)" ::: "memory");
            const unsigned og = xb_add(&bar[XB_TOP], 1u);
            const unsigned tg = og / nx;
            if (og + 1u == (tg + 1u) * nx) xb_add(&bar[XB_TOPGEN], 1u);
            else XB_SPIN(xb_ld(&bar[XB_TOPGEN]) == tg, bar);
            __builtin_amdgcn_fence(__ATOMIC_ACQUIRE, "agent");
            xb_add(&bar[XB_XGEN(b.x)], 1u);
            asm volatile("s_waitcnt vmcnt(0)" ::: "memory");
        } else {
            XB_SPIN(xb_ld(&bar[XB_XGEN(b.x)]) == gen, bar);
            __builtin_amdgcn_fence(__ATOMIC_ACQUIRE, "agent");
            asm volatile("s_waitcnt vmcnt(0)" ::: "memory");
        }
    }
    __syncthreads();
}

template <int KIND>
DI void run_gemm(LAS unsigned char* lds, int l, int ffn, int c, int sub, int dry = 0) {
    const KP p = kparams();
    unsigned char* ws = p->ws;
    pg8::EpiCtx E; E.hid = (bf16_t*)(ws + WS_HID); E.proj = (bf16_t*)(ws + WS_PROJ); E.hbuf = (KIND == 1 && l == 1 && ffn == 1) ? (bf16_t*)(ws + WS_DLAST) : (bf16_t*)p->out;
    E.mod = (const float*)(ws + WS_MOD) + (size_t)l * NB * NADA; E.merge_b = p->in[16] + (size_t)l * 3072;
    E.gscr = (bf16_t*)(ws + WS_GSCR) + (size_t)blockIdx.x * 65536; E.dry = dry;
    pg8::Sched S; S.kind = KIND; S.G = gridDim.x; S.c = c; S.sub = sub; S.A1 = nullptr; S.B1 = nullptr;
    if (KIND == 0) { S.A0 = (const char*)p->out; S.B0 = (const char*)(ws + (ffn ? WS_WUP2 : WS_WUP1)); }
    else if (KIND == 1) { S.A0 = (const char*)(ws + WS_HID); S.B0 = (const char*)(ws + (ffn ? WS_WDN2 : WS_WDN1)); }
    else if (KIND == 2) { S.A0 = (const char*)p->out; S.B0 = (const char*)(ws + WS_WIN); }
    else if (KIND == 3) { S.A0 = (const char*)p->out; S.B0 = (const char*)(ws + WS_WG); }
    else if (KIND == 5) { S.A0 = (const char*)(ws + WS_PROJ); S.B0 = (const char*)(ws + WS_WM); }
    else { S.A0 = (const char*)(ws + WS_PROJ); S.B0 = (const char*)(ws + WS_WO); }
    pg8::gemm_phase(lds, S, E);
}

__global__ void __launch_bounds__(NTHR, 2) fwd_megakernel(Params p_unused) {
    extern __shared__ __attribute__((aligned(16))) unsigned char lds_raw[];
    LAS unsigned char* lds = (LAS unsigned char*)lds_raw;
    cg::grid_group grid = cg::this_grid();
    const int G = gridDim.x, bx = blockIdx.x;
    { const KP p = kparams(); unsigned* bw = (unsigned*)p->ws;
      if (bx == 0) for (int i = threadIdx.x; i < XCD_BAR_WORDS; i += NTHR) __hip_atomic_store(bw + i, 0u, __ATOMIC_RELAXED, __HIP_MEMORY_SCOPE_AGENT);
      if (threadIdx.x < 2) ((volatile LAS unsigned*)(lds + LDS_CTL))[threadIdx.x] = 0u; }
#define GW_ARGS (int)(bx * NWAVES + __builtin_amdgcn_readfirstlane(opaque_tid() >> 6)), G * NWAVES

#ifndef NFWD
#define NFWD 1
#endif
    XcdBarrier xbar; xbar.bar = nullptr; xbar.x = 0; xbar.st = nullptr;
    for (int fwd = 0; fwd < NFWD; ++fwd) {
    if (REP(0)) for (int u = bx; u < 160; u += G) ada_unit(u, lds);
    if (RUN(0)) for (int u = bx; u < 160; u += G) ada_unit(u, lds);
    if (REP(1)) convert_weights(0, lds, GW_ARGS);
    if (RUN(1)) convert_weights(0, lds, GW_ARGS);
    if (fwd == 0) { grid.sync(); xbar = xcd_barrier_post((unsigned*)kparams()->ws, (volatile LAS unsigned*)(lds + LDS_CTL)); }
    else { XcdBarrier b_ = xbar; b_.bar = (unsigned*)kparams()->ws; xcd_barrier(b_); }
#define SEAM() do { XcdBarrier b_ = xbar; b_.bar = (unsigned*)kparams()->ws; xcd_barrier(b_); if (REP(16)) xcd_barrier(b_); } while (0)

    for (int l = 0; l < 2; ++l) {
        if (REP(1)) if (l == 1) convert_weights(1, lds, GW_ARGS);
        if (REP(2)) if (l == 0) norm_phase(l, 1, 0, lds, GW_ARGS);
        if (RUN(1)) if (l == 1) convert_weights(1, lds, GW_ARGS);
        if (RUN(2)) { if (l == 0) norm_phase(l, 1, 0, lds, GW_ARGS); else norm_phase(l, 0, 0, lds, GW_ARGS, 2, 0); }
        SEAM();
        if (REP(3)) run_gemm<0>(lds, l, 0, bx, 0, 1);
        if (RUN(3)) run_gemm<0>(lds, l, 0, bx, 0);
        SEAM();
        if (REP(4)) run_gemm<1>(lds, l, 0, bx, 0, 1);
        if (RUN(4)) run_gemm<1>(lds, l, 0, bx, 0);
        SEAM();
        if (RUN(5)) norm_phase(l, 2, 1, lds, GW_ARGS, 0, l);
        SEAM();
        if (REP(6)) run_gemm<2>(lds, l, 0, bx, 0, 1);
        if (RUN(6)) run_gemm<2>(lds, l, 0, bx, 0);
        SEAM();
        if (REPM & 0x380) {
        for (int u = bx; u < 256 + 2048; u += G) {
            if (u < 256) { if (REP(7)) rg_unit(l, u >> 4, u & 15, lds, 1); }
            else { const int a = u - 256, lv = a >> 8, cc = a & 255, qb = 7 - lv, bh = cc >> 1; const int ty = (((0x99 >> qb) ^ cc) & 1) ? 0 : 1;
                if (ty == 0) { if (REP(8)) attn_unit<true>(bh >> 3, bh & 7, qb, lds, 1); } else { if (REP(9)) attn_unit<false>(bh >> 3, bh & 7, qb, lds, 1); } }
        }
        }
        for (int u = bx; u < 256 + 2048; u += G) {
            if (u < 256) { if (RUN(7)) rg_unit(l, u >> 4, u & 15, lds); }
            else { const int a = u - 256, lv = a >> 8, cc = a & 255, qb = 7 - lv, bh = cc >> 1;
                const int ty = (((0x99 >> qb) ^ cc) & 1) ? 0 : 1;
                if (ty == 0) { if (RUN(8)) attn_unit<true>(bh >> 3, bh & 7, qb, lds); } else { if (RUN(9)) attn_unit<false>(bh >> 3, bh & 7, qb, lds); } }
        }
        SEAM();
        if (RUN(10)) {
            for (int L = bx; L < 512; L += G)
                for (int j = 0; j < 3; ++j) { if (REP(10)) { run_gemm<3>(lds, l, 0, L, j, 1); run_gemm<5>(lds, l, 0, L, j, 1); } run_gemm<3>(lds, l, 0, L, j); run_gemm<5>(lds, l, 0, L, j); }
        }
        SEAM();
        if (REP(11)) run_gemm<4>(lds, l, 0, bx, 1, 1);
        if (RUN(11)) run_gemm<4>(lds, l, 0, bx, 1);
        SEAM();
        if (RUN(12)) norm_phase(l, 0, 2, lds, GW_ARGS, 1, l);
        SEAM();
        if (REP(13)) run_gemm<0>(lds, l, 1, bx, 0, 1);
        if (RUN(13)) run_gemm<0>(lds, l, 1, bx, 0);
        SEAM();
        if (REP(14)) run_gemm<1>(lds, l, 1, bx, 2, 1);
        if (RUN(14)) run_gemm<1>(lds, l, 1, bx, 2);
        SEAM();
    }
    if (RUN(15)) norm_phase(0, 3, 0, lds, GW_ARGS, 2, 1);
    if (fwd + 1 < NFWD) SEAM();
    }
}

extern "C" void kernel_launch(void* const* d_in, const int* in_sizes, int n_in, void* d_out, int out_size, void* d_ws, size_t ws_size, hipStream_t stream) {
    static int grid = 0;
    if (grid == 0) {
        if (n_in != 30 || out_size != M * DM || ws_size < WS_END) { fprintf(stderr, "kernel_launch: unexpected shapes (n_in %d out %d ws %zu)\n", n_in, out_size, ws_size); grid = -1; return; }
        int dev = 0, cus = 0, per_cu = 0;
        (void)hipGetDevice(&dev);
        (void)hipDeviceGetAttribute(&cus, hipDeviceAttributeMultiprocessorCount, dev);
        if (hipFuncSetAttribute((const void*)fwd_megakernel, hipFuncAttributeMaxDynamicSharedMemorySize, LDS_BYTES) != hipSuccess) { fprintf(stderr, "kernel_launch: hipFuncSetAttribute failed\n"); grid = -1; return; }
        if (hipOccupancyMaxActiveBlocksPerMultiprocessor(&per_cu, (const void*)fwd_megakernel, NTHR, LDS_BYTES) != hipSuccess || per_cu < 1) per_cu = 1;
        (void)hipGetLastError();
        grid = cus >= 256 ? 256 : cus;
        (void)per_cu;
    }
    if (grid < 0) return;
    Params p{};
    for (int i = 0; i < 30; ++i) p.in[i] = (const float*)d_in[i];
    p.out = (float*)d_out; p.ws = (unsigned char*)d_ws;
    void* args[] = {&p};
    hipError_t e = hipLaunchCooperativeKernel((const void*)fwd_megakernel, dim3(grid), dim3(NTHR), args, LDS_BYTES, stream);
    if (e != hipSuccess) fprintf(stderr, "cooperative launch failed: %s (grid %d)\n", hipGetErrorString(e), grid);
}
```
